# Optimizing an MI355X kernel written in HIP

```python
import jax
import jax.numpy as jnp
from jax import lax
import numpy as np

D_MODEL = 1024
BATCH = 8
SEQ = 2048
DEPTH = 4

GRID_W = 64
CTX_LEN = 256
EPS = 1e-6
NEG_INF = -1e30
ROPE_THETA = 10000.0

N_BRANCH = 3
BRANCH_WIDTH = 512

GDN_HEADS = 4
GDN_DK = 128
GDN_DV = 128
GDN_CHUNK = 64
GDN_CONV = 4

SWA_Q_HEADS = 8
SWA_KV_HEADS = 2
SWA_GROUP = SWA_Q_HEADS // SWA_KV_HEADS
SWA_HEAD_DIM = 64
SWA_WINDOW = 128
SWA_BLOCK = 128

LRU_WIDTH = 512
LRU_BLOCKS = 8
LRU_CONV = 4
LRU_C = 8.0

N_EXPERTS = 16
EXPERT_HIDDEN = 2048
EC_CAPACITY = 2

IN_SIZES = (GDN_HEADS * GDN_DK, GDN_HEADS * GDN_DK, GDN_HEADS * GDN_DV, GDN_HEADS * GDN_DV,
            2 * GDN_HEADS, 2 * GDN_HEADS,
            SWA_Q_HEADS * SWA_HEAD_DIM, SWA_KV_HEADS * SWA_HEAD_DIM, SWA_KV_HEADS * SWA_HEAD_DIM,
            LRU_WIDTH, LRU_WIDTH,
            N_BRANCH * D_MODEL)
IN_SPLITS = tuple(sum(IN_SIZES[:i + 1]) for i in range(len(IN_SIZES) - 1))
D_IN = sum(IN_SIZES)

kernel_name = 'hybrid_gdn_swa_rglru_ecmoe_prefix_dit'

F32 = jnp.float32


def rmsnorm(t, g):
    tf = t.astype(F32)
    tf = tf * lax.rsqrt(jnp.mean(tf * tf, axis=-1, keepdims=True) + EPS)
    return (tf * g.astype(F32)).astype(t.dtype)


def l2norm(t):
    tf = t.astype(F32)
    return tf * lax.rsqrt(jnp.sum(tf * tf, axis=-1, keepdims=True) + EPS)


def split_heads(t, n):
    return t.reshape(t.shape[:-1] + (n, t.shape[-1] // n))


def maybe_flip(t, rev):
    return jnp.flip(t, axis=1) if rev else t


def centred_depthwise_conv(t, w):
    k = w.shape[0]
    return lax.conv_general_dilated(
        t, w[:, None, :].astype(t.dtype), window_strides=(1,),
        padding=[(k // 2, k - 1 - k // 2)], dimension_numbers=('NWC', 'WIO', 'NWC'),
        feature_group_count=t.shape[-1])


def adaln(cond, w, b):
    return jnp.split(jax.nn.silu(cond) @ w + b, 6, axis=-1)


def modulate(t, shift, scale):
    return t * (1 + scale) + shift


def unit_lower_inverse(a):
    c = a.shape[-1]
    eye = jnp.eye(c, dtype=a.dtype)
    inv = eye - a
    p = a
    for _ in range(int(np.log2(c)) - 1):
        p = p @ p
        inv = inv @ (eye + p)
    return inv


def gdn_chunked(q, k, v, g, beta, s0):
    b, l, h, _ = q.shape
    c = GDN_CHUNK
    n = l // c

    def blocks(t):
        return jnp.moveaxis(t.reshape((b, n, c, h) + t.shape[3:]), (1, 2), (0, 3))

    qb, kb, vb, betab = blocks(q), blocks(k), blocks(v), blocks(beta)
    gb = jnp.cumsum(blocks(g), axis=-1)
    incl = jnp.tril(jnp.ones((c, c), bool))
    strict = jnp.tril(jnp.ones((c, c), bool), -1)
    diff = gb[..., :, None] - gb[..., None, :]
    decay = jnp.where(incl, jnp.exp(jnp.where(incl, diff, 0.0)), 0.0)
    k_beta = kb * betab[..., None]
    a_mat = jnp.where(strict, jnp.einsum('nbhid,nbhjd->nbhij', k_beta, kb) * decay, 0.0)
    t_mat = unit_lower_inverse(a_mat)
    u = t_mat @ (vb * betab[..., None])
    w = t_mat @ (k_beta * jnp.exp(gb)[..., None])
    qk = jnp.einsum('nbhid,nbhjd->nbhij', qb, kb) * decay

    def step(s, inp):
        q_c, k_c, u_c, w_c, qk_c, g_c = inp
        v_new = u_c - w_c @ s
        o = (q_c * jnp.exp(g_c)[..., None]) @ s + qk_c @ v_new
        g_last = g_c[..., -1:]
        s = s * jnp.exp(g_last)[..., None] + jnp.einsum(
            'bhcd,bhce->bhde', k_c * jnp.exp(g_last - g_c)[..., None], v_new)
        return s, o

    s_fin, o = lax.scan(step, s0, (qb, kb, u, w, qk, gb))
    o = jnp.moveaxis(o, (0, 3), (1, 2)).reshape(b, l, h, v.shape[-1])
    return o, s_fin


def gdn_prepare(q, k, v, conv_w):
    qkv = jax.nn.silu(centred_depthwise_conv(jnp.concatenate([q, k, v], axis=-1), conv_w))
    q, k, v = jnp.split(qkv, [GDN_HEADS * GDN_DK, 2 * GDN_HEADS * GDN_DK], axis=-1)
    q = l2norm(split_heads(q, GDN_HEADS)) * (GDN_DK ** -0.5)
    k = l2norm(split_heads(k, GDN_HEADS))
    v = split_heads(v, GDN_HEADS).astype(F32)
    return q, k, v


def gdn_gates(a, b, a_log, dt_bias, d):
    sl = slice(d * GDN_HEADS, (d + 1) * GDN_HEADS)
    g = -jnp.exp(a_log[d].astype(F32)) * jax.nn.softplus(a[..., sl].astype(F32) + dt_bias[d].astype(F32))
    beta = jax.nn.sigmoid(b[..., sl].astype(F32))
    return g, beta


def gdn_mixer(parts_x, parts_c, conv_w, a_log, dt_bias, onorm_g, need_ctx):
    qx, kx, vx, zx, ax, bx = parts_x
    qc, kc, vc, zc, ac, bc = parts_c
    seq_x = gdn_prepare(qx, kx, vx, conv_w)
    seq_c = gdn_prepare(qc, kc, vc, conv_w)
    batch = qx.shape[0]
    o_x = jnp.zeros(seq_x[2].shape, F32)
    o_c = jnp.zeros(seq_c[2].shape, F32)
    for d in range(2):
        rev = d == 1
        gx, betax = gdn_gates(ax, bx, a_log, dt_bias, d)
        gc, betac = gdn_gates(ac, bc, a_log, dt_bias, d)
        s0 = jnp.zeros((batch, GDN_HEADS, GDN_DK, GDN_DV), F32)
        oc_d, s_ctx = gdn_chunked(*(maybe_flip(t, rev) for t in (*seq_c, gc, betac)), s0)
        ox_d, _ = gdn_chunked(*(maybe_flip(t, rev) for t in (*seq_x, gx, betax)), s_ctx)
        o_x = o_x + maybe_flip(ox_d, rev)
        o_c = o_c + maybe_flip(oc_d, rev)

    def finish(o, z):
        y = rmsnorm(o, onorm_g) * jax.nn.silu(split_heads(z, GDN_HEADS).astype(F32))
        return y.reshape(z.shape).astype(z.dtype)

    return finish(o_x, zx), (finish(o_c, zc) if need_ctx else None)


def axial_rope(length, dh):
    rows = length // GRID_W
    row = jnp.repeat(jnp.arange(rows, dtype=F32), GRID_W)
    col = jnp.tile(jnp.arange(GRID_W, dtype=F32), rows)
    axis_dim = dh // 2
    inv_freq = ROPE_THETA ** (-jnp.arange(0, axis_dim, 2, dtype=F32) / axis_dim)
    ang = jnp.concatenate([row[:, None] * inv_freq, col[:, None] * inv_freq], axis=-1)
    return jnp.cos(ang), jnp.sin(ang)


def apply_rope(t, cos, sin):
    tf = t.astype(F32)
    t1, t2 = tf[..., 0::2], tf[..., 1::2]
    cs, sn = cos[None, :, None, :], sin[None, :, None, :]
    out = jnp.stack([t1 * cs - t2 * sn, t1 * sn + t2 * cs], axis=-1).reshape(t.shape)
    return out.astype(t.dtype)


def band_mask(nb, length):
    a = jnp.arange(SWA_BLOCK)[:, None]
    s = jnp.arange(3 * SWA_BLOCK)[None, :]
    kpos = jnp.arange(nb)[:, None, None] * SWA_BLOCK - SWA_BLOCK + s
    in_window = jnp.abs(s - SWA_BLOCK - a) <= SWA_WINDOW
    return in_window[None] & (kpos >= 0) & (kpos < length)


def swa_mixer(qx, kx, vx, qc, kc, vc, qn_g, kn_g, sink, need_ctx):
    b, l, _ = qx.shape
    lc = qc.shape[1]
    scale = SWA_HEAD_DIM ** -0.5
    cos, sin = axial_rope(l, SWA_HEAD_DIM)
    qx = apply_rope(rmsnorm(split_heads(qx, SWA_Q_HEADS), qn_g), cos, sin)
    kx = apply_rope(rmsnorm(split_heads(kx, SWA_KV_HEADS), kn_g), cos, sin)
    vx = split_heads(vx, SWA_KV_HEADS)
    qc = rmsnorm(split_heads(qc, SWA_Q_HEADS), qn_g)
    kc = rmsnorm(split_heads(kc, SWA_KV_HEADS), kn_g)
    vc = split_heads(vc, SWA_KV_HEADS)
    sink_l = sink.astype(F32).reshape(SWA_KV_HEADS, SWA_GROUP)

    nb = l // SWA_BLOCK
    qb = qx.reshape(b, nb, SWA_BLOCK, SWA_KV_HEADS, SWA_GROUP, SWA_HEAD_DIM)

    def windows(t):
        tp = jnp.pad(t, ((0, 0), (SWA_BLOCK, SWA_BLOCK), (0, 0), (0, 0)))
        tp = tp.reshape(b, nb + 2, SWA_BLOCK, SWA_KV_HEADS, SWA_HEAD_DIM)
        return jnp.concatenate([tp[:, :-2], tp[:, 1:-1], tp[:, 2:]], axis=2)

    kw, vw = windows(kx), windows(vx)
    s_loc = jnp.einsum('bnqkgd,bnskd->bnkgqs', qb, kw).astype(F32) * scale
    s_loc = jnp.where(band_mask(nb, l)[None, :, None, None], s_loc, NEG_INF)
    s_ctx = jnp.einsum('bnqkgd,bskd->bnkgqs', qb, kc).astype(F32) * scale
    sink_col = jnp.broadcast_to(sink_l[None, None, :, :, None, None], s_loc.shape[:-1] + (1,))
    p = jax.nn.softmax(jnp.concatenate([s_loc, s_ctx, sink_col], axis=-1), axis=-1).astype(vx.dtype)
    w3 = 3 * SWA_BLOCK
    o = (jnp.einsum('bnkgqs,bnskd->bnqkgd', p[..., :w3], vw)
         + jnp.einsum('bnkgqs,bskd->bnqkgd', p[..., w3:w3 + lc], vc))
    out_x = o.reshape(b, l, SWA_Q_HEADS * SWA_HEAD_DIM)
    if not need_ctx:
        return out_x, None

    qcg = qc.reshape(b, lc, SWA_KV_HEADS, SWA_GROUP, SWA_HEAD_DIM)
    s = jnp.einsum('bqkgd,bskd->bkgqs', qcg, kc).astype(F32) * scale
    sink_c = jnp.broadcast_to(sink_l[None, :, :, None, None], s.shape[:-1] + (1,))
    pc = jax.nn.softmax(jnp.concatenate([s, sink_c], axis=-1), axis=-1)[..., :lc].astype(vc.dtype)
    out_c = jnp.einsum('bkgqs,bskd->bqkgd', pc, vc).reshape(b, lc, SWA_Q_HEADS * SWA_HEAD_DIM)
    return out_x, out_c


def linear_scan(a, bterm, h0):
    bterm = bterm.at[:, 0].add(a[:, 0] * h0)

    def combine(lft, rgt):
        return lft[0] * rgt[0], rgt[0] * lft[1] + rgt[1]

    _, h = lax.associative_scan(combine, (a, bterm), axis=1)
    return h


def lru_coeffs(u, gate_w, gate_b, lam):
    b, l, _ = u.shape
    ub = u.reshape(b, l, LRU_BLOCKS, LRU_WIDTH // LRU_BLOCKS)
    pre = jnp.einsum('blki,gkij->gblkj', ub, gate_w.astype(F32)).reshape(2, b, l, LRU_WIDTH)
    pre = pre + gate_b.astype(F32)[:, None, None, :]
    r, i = jax.nn.sigmoid(pre[0]), jax.nn.sigmoid(pre[1])
    log_a = -LRU_C * r * jax.nn.softplus(-lam.astype(F32))
    return jnp.exp(log_a), jnp.sqrt(-jnp.expm1(2.0 * log_a)) * (i * u)


def lru_mixer(xr_x, y_x, xr_c, y_c, conv_w, conv_b, gate_w, gate_b, lam, need_ctx):
    ux = (centred_depthwise_conv(xr_x, conv_w) + conv_b).astype(F32)
    uc = (centred_depthwise_conv(xr_c, conv_w) + conv_b).astype(F32)
    batch = ux.shape[0]
    h_x = jnp.zeros(ux.shape, F32)
    h_c = jnp.zeros(uc.shape, F32)
    for d in range(2):
        rev = d == 1
        ac, bc = lru_coeffs(maybe_flip(uc, rev), gate_w[d], gate_b[d], lam[d])
        ax, bx = lru_coeffs(maybe_flip(ux, rev), gate_w[d], gate_b[d], lam[d])
        hc_d = linear_scan(ac, bc, jnp.zeros((batch, LRU_WIDTH), F32))
        hx_d = linear_scan(ax, bx, hc_d[:, -1])
        h_x = h_x + maybe_flip(hx_d, rev)
        h_c = h_c + maybe_flip(hc_d, rev)
    out_x = (h_x * jax.nn.gelu(y_x.astype(F32))).astype(y_x.dtype)
    out_c = (h_c * jax.nn.gelu(y_c.astype(F32))).astype(y_c.dtype) if need_ctx else None
    return out_x, out_c


def merge(branches, gate_logits, w_branch, w_out):
    gates = jnp.split(jax.nn.sigmoid(gate_logits.astype(F32)).astype(gate_logits.dtype), N_BRANCH, axis=-1)
    mixed = gates[0] * (branches[0] @ w_branch[0])
    for i in range(1, N_BRANCH):
        mixed = mixed + gates[i] * (branches[i] @ w_branch[i])
    return mixed @ w_out


def mixer_sublayer(hx, hc, w_in, gdn_conv_w, gdn_a_log, gdn_dt_bias, gdn_onorm_g,
                   swa_qnorm_g, swa_knorm_g, swa_sink, lru_conv_w, lru_conv_b,
                   lru_gate_w, lru_gate_b, lru_lambda, w_branch, w_out, need_ctx):
    px = jnp.split(hx @ w_in, IN_SPLITS, axis=-1)
    pc = jnp.split(hc @ w_in, IN_SPLITS, axis=-1)
    a_x, a_c = gdn_mixer(px[0:6], pc[0:6], gdn_conv_w, gdn_a_log, gdn_dt_bias, gdn_onorm_g, need_ctx)
    b_x, b_c = swa_mixer(*px[6:9], *pc[6:9], swa_qnorm_g, swa_knorm_g, swa_sink, need_ctx)
    c_x, c_c = lru_mixer(px[9], px[10], pc[9], pc[10], lru_conv_w, lru_conv_b,
                         lru_gate_w, lru_gate_b, lru_lambda, need_ctx)
    out_x = merge((a_x, b_x, c_x), px[11], w_branch, w_out)
    out_c = merge((a_c, b_c, c_c), pc[11], w_branch, w_out) if need_ctx else None
    return out_x, out_c


def expert_choice_ffn(h, w_router, w_gate, w_up, w_down):
    b, t, _ = h.shape
    cap = EC_CAPACITY * t // N_EXPERTS
    aff = jax.nn.softmax((h @ w_router).astype(F32), axis=-1)
    gates, idx = lax.top_k(jnp.swapaxes(aff, 1, 2), cap)
    bidx = jnp.arange(b)[:, None, None]
    xs = h[bidx, idx]
    hid = jax.nn.silu(jnp.einsum('becd,edf->becf', xs, w_gate)) * jnp.einsum('becd,edf->becf', xs, w_up)
    ys = jnp.einsum('becf,efd->becd', hid, w_down) * gates[..., None].astype(h.dtype)
    return jnp.zeros_like(h).at[bidx, idx].add(ys.astype(h.dtype))


def setup_inputs(seed: int = 0) -> dict:
    key = jax.random.key(seed)
    ks = jax.random.split(key, 32)

    def nrm(i, shape, scale):
        return jax.random.normal(ks[i], shape, F32) * scale

    dt = jnp.exp(jax.random.uniform(ks[9], (DEPTH, 2, GDN_HEADS), F32, np.log(1e-3), np.log(1e-1)))
    u = jax.random.uniform(ks[18], (DEPTH, 2, LRU_WIDTH), F32, 0.9, 0.999)
    a0 = u ** (1.0 / LRU_C)
    bw = LRU_WIDTH // LRU_BLOCKS
    return {
        'x': nrm(0, (BATCH, SEQ, D_MODEL), 1.0),
        'c': nrm(1, (BATCH, D_MODEL), 1.0),
        'ctx': nrm(2, (BATCH, CTX_LEN, D_MODEL), 1.0),
        'c_ctx': nrm(3, (D_MODEL,), 1.0),
        'w_ada': nrm(4, (DEPTH, D_MODEL, 6 * D_MODEL), 0.5 * D_MODEL ** -0.5),
        'b_ada': nrm(5, (DEPTH, 6 * D_MODEL), 0.01),
        'norm1_g': 1.0 + nrm(6, (DEPTH, D_MODEL), 0.01),
        'norm2_g': 1.0 + nrm(7, (DEPTH, D_MODEL), 0.01),
        'w_in': nrm(8, (DEPTH, D_MODEL, D_IN), D_MODEL ** -0.5),
        'gdn_conv_w': nrm(10, (DEPTH, GDN_CONV, 2 * GDN_HEADS * GDN_DK + GDN_HEADS * GDN_DV), GDN_CONV ** -0.5),
        'gdn_a_log': jnp.log(jax.random.uniform(ks[11], (DEPTH, 2, GDN_HEADS), F32, 1.0, 16.0)),
        'gdn_dt_bias': dt + jnp.log(-jnp.expm1(-dt)),
        'gdn_onorm_g': 1.0 + nrm(12, (DEPTH, GDN_DV), 0.01),
        'swa_qnorm_g': 1.0 + nrm(13, (DEPTH, SWA_HEAD_DIM), 0.01),
        'swa_knorm_g': 1.0 + nrm(14, (DEPTH, SWA_HEAD_DIM), 0.01),
        'swa_sink': nrm(15, (DEPTH, SWA_Q_HEADS), 0.5),
        'lru_conv_w': nrm(16, (DEPTH, LRU_CONV, LRU_WIDTH), LRU_CONV ** -0.5),
        'lru_conv_b': nrm(17, (DEPTH, LRU_WIDTH), 0.01),
        'lru_gate_w': nrm(19, (DEPTH, 2, 2, LRU_BLOCKS, bw, bw), bw ** -0.5),
        'lru_gate_b': nrm(20, (DEPTH, 2, 2, LRU_WIDTH), 0.01),
        'lru_lambda': jnp.log(a0) - jnp.log1p(-a0),
        'w_branch': nrm(21, (DEPTH, N_BRANCH, BRANCH_WIDTH, D_MODEL), BRANCH_WIDTH ** -0.5),
        'w_out': nrm(22, (DEPTH, D_MODEL, D_MODEL), D_MODEL ** -0.5),
        'w_router': nrm(23, (DEPTH, D_MODEL, N_EXPERTS), D_MODEL ** -0.5),
        'w_exp_gate': nrm(24, (DEPTH, N_EXPERTS, D_MODEL, EXPERT_HIDDEN), D_MODEL ** -0.5),
        'w_exp_up': nrm(25, (DEPTH, N_EXPERTS, D_MODEL, EXPERT_HIDDEN), D_MODEL ** -0.5),
        'w_exp_down': nrm(26, (DEPTH, N_EXPERTS, EXPERT_HIDDEN, D_MODEL), EXPERT_HIDDEN ** -0.5),
    }


def reference(x, c, ctx, c_ctx, w_ada, b_ada, norm1_g, norm2_g, w_in, gdn_conv_w, gdn_a_log,
              gdn_dt_bias, gdn_onorm_g, swa_qnorm_g, swa_knorm_g, swa_sink, lru_conv_w,
              lru_conv_b, lru_gate_w, lru_gate_b, lru_lambda, w_branch, w_out, w_router,
              w_exp_gate, w_exp_up, w_exp_down):
    cond_x = c[:, None, :]
    cond_c = c_ctx[None, None, :]
    cx = ctx
    for layer in range(DEPTH):
        need_ctx = layer < DEPTH - 1
        mx = adaln(cond_x, w_ada[layer], b_ada[layer])
        mc = adaln(cond_c, w_ada[layer], b_ada[layer])
        hx = modulate(rmsnorm(x, norm1_g[layer]), mx[0], mx[1])
        hc = modulate(rmsnorm(cx, norm1_g[layer]), mc[0], mc[1])
        ox, oc = mixer_sublayer(hx, hc, w_in[layer], gdn_conv_w[layer], gdn_a_log[layer],
                                gdn_dt_bias[layer], gdn_onorm_g[layer], swa_qnorm_g[layer],
                                swa_knorm_g[layer], swa_sink[layer], lru_conv_w[layer],
                                lru_conv_b[layer], lru_gate_w[layer], lru_gate_b[layer],
                                lru_lambda[layer], w_branch[layer], w_out[layer], need_ctx)
        x = x + mx[2] * ox
        hx = modulate(rmsnorm(x, norm2_g[layer]), mx[3], mx[4])
        x = x + mx[5] * expert_choice_ffn(hx, w_router[layer], w_exp_gate[layer],
                                          w_exp_up[layer], w_exp_down[layer])
        if need_ctx:
            cx = cx + mc[2] * oc
            hc = modulate(rmsnorm(cx, norm2_g[layer]), mc[3], mc[4])
            cx = cx + mc[5] * expert_choice_ffn(hc, w_router[layer], w_exp_gate[layer],
                                                w_exp_up[layer], w_exp_down[layer])
    return x
```

```cpp
#include <hip/hip_runtime.h>
#include <cstdio>
#include <utility>

constexpr int D_MODEL = 1024, BATCH = 8, SEQ = 2048, DEPTH = 4, CTX = 256, GH = 4, GDK = 128, QH = 8, KVH = 2, HD = 64, LW = 512, LB = 8, NE = 16, EH = 2048;
constexpr int GRID_W = 64, SWA_WINDOW = 128, ECAP = 2, NBR = 3;
constexpr int D = D_MODEL, BW = GH * GDK, SGRP = QH / KVH, LBW = LW / LB;
constexpr float EPS = 1e-6f;
constexpr int BX = BATCH * SEQ, BC = BATCH * CTX, NR = BX + BC, NCOND = BATCH + 1;
constexpr int C_Q = 0, C_K = BW, C_V = 2 * BW, C_Z = 3 * BW, C_A = 4 * BW, C_B = C_A + 2 * GH, C_SQ = C_B + 2 * GH, C_SK = C_SQ + QH * HD, C_SV = C_SK + KVH * HD,
              C_LX = C_SV + KVH * HD, C_LY = C_LX + LW, C_G = C_LY + LW, D_IN = C_G + NBR * D;
constexpr int LDP = 7168;
constexpr int CAPX = ECAP * SEQ / NE, CAPC = ECAP * CTX / NE, ME = BATCH * (CAPX + CAPC);
static_assert(C_G % 8 == 0 && BW == QH * HD && BW == LW && D_IN <= LDP && LDP % 256 == 0 && NR % 256 == 0 && ME % 256 == 0, "shapes");

typedef unsigned short bf16_t;
constexpr int NWG = 256  , NTHREADS = 512, LDS_BAR_OFF = 160 * 1024 - 256  , LDS_BYTES = 160 * 1024;
__device__ __forceinline__ float bf2f(bf16_t b) { return __uint_as_float(((unsigned)b) << 16); }
__device__ __forceinline__ bf16_t f2bf(float f) { unsigned u = __float_as_uint(f); u += 0x7FFFu + ((u >> 16) & 1u); return (bf16_t)(u >> 16); }

constexpr int XCD_BAR_WORDS_C = 3456, NCHUNK_C = (BX + BC) / 64, NPROB_C = NCHUNK_C * GH * 2;
constexpr size_t al256(size_t x) { return (x + 255) & ~(size_t)255; }
static_assert(NCHUNK_C > NWG && NCHUNK_C - NWG <= NWG / 2, "lru_local deals its second-round chunks to workgroups NWG/2..");
constexpr size_t O_bar = 0;
constexpr size_t O_X = O_bar + al256((size_t)XCD_BAR_WORDS_C * 4);
constexpr size_t O_MOD = O_X + al256((size_t)NR * D * 4);
constexpr size_t O_HXb = O_MOD + al256((size_t)DEPTH * NCOND * 6 * D * 4);
constexpr size_t O_Pb = O_HXb + al256((size_t)NR * D * 2);
constexpr size_t O_GFR = O_Pb + al256((size_t)NR * LDP * 2);
constexpr size_t O_GU = O_GFR + al256((size_t)NPROB_C * 56 * 1024);
constexpr size_t O_GEG = O_GU + al256((size_t)NPROB_C * 8192 * 4);
constexpr size_t O_GO = O_GEG + al256((size_t)(NPROB_C + 64) * 4);
constexpr size_t O_SQb = O_GO + al256((size_t)2 * NR * BW * 4);
constexpr size_t O_SKb = O_SQb + al256((size_t)NR * QH * HD * 2);
constexpr size_t O_LA = O_SKb + al256((size_t)NR * KVH * HD * 2);
constexpr size_t O_LH = O_LA + al256((size_t)2 * NR * LW * 4);
constexpr size_t O_LSA = O_LH + al256((size_t)2 * NR * LW * 4);
constexpr size_t O_LSH = O_LSA + al256((size_t)2 * NCHUNK_C * LW * 4);
constexpr size_t O_LSC = O_LSH + al256((size_t)2 * NCHUNK_C * LW * 4);
constexpr size_t O_BRb = O_LSC + al256((size_t)2 * NCHUNK_C * LW * 4);
constexpr size_t O_MIXb = O_BRb + al256((size_t)NR * 3 * BW * 2);
constexpr size_t O_AFF = O_MIXb + al256((size_t)NR * D * 2);
constexpr size_t O_RANK = O_AFF + al256((size_t)NR * NE * 4);
constexpr size_t O_IDX = O_RANK + al256((size_t)NR * NE * 4);
constexpr size_t O_HIDb = O_IDX + al256((size_t)NE * ME * 4);
constexpr size_t O_YSb = O_HIDb + al256((size_t)NE * ME * EH * 2);
constexpr size_t O_Wt_in = O_YSb + al256((size_t)NE * ME * D * 2);
constexpr size_t O_Wt_br = O_Wt_in + al256((size_t)LDP * D * 2);
constexpr size_t O_Wt_out = O_Wt_br + al256((size_t)NBR * D * BW * 2);
constexpr size_t O_Wt_gu = O_Wt_out + al256((size_t)D * D * 2);
constexpr size_t O_Wt_d = O_Wt_gu + al256((size_t)NE * 2 * EH * D * 2);
constexpr size_t WSET = O_Wt_d + al256((size_t)NE * D * EH * 2) - O_Wt_in;
constexpr size_t O_Wt_lg = O_Wt_in + 2 * WSET;
constexpr size_t O_BP = O_Wt_lg + al256((size_t)4 * LB * LBW * LBW * 2);
constexpr size_t O_OP = O_BP + al256((size_t)6 * BC * D * 2);
constexpr size_t WS_END = O_OP + al256((size_t)6 * BC * D * 4);
struct Ptrs {
    const float *x, *c, *ctx, *c_ctx, *w_ada, *b_ada, *norm1_g, *norm2_g, *w_in, *gdn_conv_w, *gdn_a_log, *gdn_dt_bias, *gdn_onorm_g, *swa_qnorm_g, *swa_knorm_g, *swa_sink,
        *lru_conv_w, *lru_conv_b, *lru_gate_w, *lru_gate_b, *lru_lambda, *w_branch, *w_out, *w_router, *w_exp_gate, *w_exp_up, *w_exp_down;
    float* out; char* ws; size_t wofs;
    __device__ __forceinline__ float* X_() const { return (float*)(ws + O_X); }
    __device__ __forceinline__ float* MOD_() const { return (float*)(ws + O_MOD); }
    __device__ __forceinline__ bf16_t* HXb_() const { return (bf16_t*)(ws + O_HXb); }
    __device__ __forceinline__ bf16_t* Pb_() const { return (bf16_t*)(ws + O_Pb); }
    __device__ __forceinline__ bf16_t* GFR_() const { return (bf16_t*)(ws + O_GFR); }
    __device__ __forceinline__ float* GU_() const { return (float*)(ws + O_GU); }
    __device__ __forceinline__ float* GEG_() const { return (float*)(ws + O_GEG); }
    __device__ __forceinline__ float* GO_() const { return (float*)(ws + O_GO); }
    __device__ __forceinline__ bf16_t* SQb_() const { return (bf16_t*)(ws + O_SQb); }
    __device__ __forceinline__ bf16_t* SKb_() const { return (bf16_t*)(ws + O_SKb); }
    __device__ __forceinline__ float* LA_() const { return (float*)(ws + O_LA); }
    __device__ __forceinline__ float* LH_() const { return (float*)(ws + O_LH); }
    __device__ __forceinline__ float* LSA_() const { return (float*)(ws + O_LSA); }
    __device__ __forceinline__ float* LSH_() const { return (float*)(ws + O_LSH); }
    __device__ __forceinline__ float* LSC_() const { return (float*)(ws + O_LSC); }
    __device__ __forceinline__ bf16_t* BRb_() const { return (bf16_t*)(ws + O_BRb); }
    __device__ __forceinline__ bf16_t* MIXb_() const { return (bf16_t*)(ws + O_MIXb); }
    __device__ __forceinline__ float* AFF_() const { return (float*)(ws + O_AFF); }
    __device__ __forceinline__ int* RANK_() const { return (int*)(ws + O_RANK); }
    __device__ __forceinline__ int* IDX_() const { return (int*)(ws + O_IDX); }
    __device__ __forceinline__ bf16_t* HIDb_() const { return (bf16_t*)(ws + O_HIDb); }
    __device__ __forceinline__ bf16_t* YSb_() const { return (bf16_t*)(ws + O_YSb); }
    __device__ __forceinline__ bf16_t* Wt_in_() const { return (bf16_t*)(ws + O_Wt_in + wofs); }
    __device__ __forceinline__ bf16_t* Wt_br_() const { return (bf16_t*)(ws + O_Wt_br + wofs); }
    __device__ __forceinline__ bf16_t* Wt_out_() const { return (bf16_t*)(ws + O_Wt_out + wofs); }
    __device__ __forceinline__ bf16_t* Wt_gu_() const { return (bf16_t*)(ws + O_Wt_gu + wofs); }
    __device__ __forceinline__ bf16_t* Wt_d_() const { return (bf16_t*)(ws + O_Wt_d + wofs); }
    __device__ __forceinline__ bf16_t* Wt_lg_() const { return (bf16_t*)(ws + O_Wt_lg); }
    __device__ __forceinline__ bf16_t* BP_() const { return (bf16_t*)(ws + O_BP); }
    __device__ __forceinline__ float* OP_() const { return (float*)(ws + O_OP); }
};

__device__ __forceinline__ float fexp(float x) { return __builtin_amdgcn_exp2f(x * 1.4426950408889634f); }
__device__ __forceinline__ float sigmoidf_(float x) { return __builtin_amdgcn_rcpf(1.0f + fexp(-x)); }
__device__ __forceinline__ float siluf_(float x) { return x * __builtin_amdgcn_rcpf(1.0f + fexp(-x)); }
__device__ __forceinline__ float softplusf_(float x) { return x > 20.f ? x : (x < -20.f ? expf(x) : log1pf(expf(x))); }
__device__ __forceinline__ float geluf_(float x) { const float t = 0.7978845608028654f * (x + 0.044715f * x * x * x); return x * __builtin_amdgcn_rcpf(1.0f + fexp(-2.0f * t)); }
__device__ __forceinline__ void row_info(int r, int& ci, int& t, int& len, int& base, int& b) {
    if (r < BX) { b = r / SEQ; t = r - b * SEQ; len = SEQ; base = b * SEQ; ci = b; }
    else { const int q = r - BX; b = q / CTX; t = q - b * CTX; len = CTX; base = BX + b * CTX; ci = BATCH; }
}
__device__ __forceinline__ float ldP(const Ptrs& p, long r, int c) { return bf2f(p.Pb_()[r * LDP + c]); }
__device__ __forceinline__ long opq(long v) { asm volatile("" : "+v"(v)); return v; }
__device__ __forceinline__ int opq(int v) { asm volatile("" : "+v"(v)); return v; }
__device__ __forceinline__ float zero_f() { float z; asm volatile("v_mov_b32 %0, 0" : "=v"(z)); return z; }

namespace pg8 {
#define PG8_LAS __attribute__((address_space(3)))
typedef short bf16x8 __attribute__((ext_vector_type(8)));
typedef float f32x4 __attribute__((ext_vector_type(4)));
typedef unsigned u32x4 __attribute__((ext_vector_type(4)));
typedef unsigned u32x2 __attribute__((ext_vector_type(2)));
constexpr int BM = 256, BK = 64, HALF = 128, HTB = HALF * BK * 2  , STAGE_BYTES = 8 * HTB, NXCD = 8, WGM = 8;
__device__ __forceinline__ int lds_byte(int r, int c) { const int st = (r >> 4) * 2 + (c >> 5), rr = r & 15, cc = c & 31, ob = rr * 64 + cc * 2; return st * 1024 + (ob ^ (((ob >> 9) & 1) << 5)); }
__device__ __forceinline__ void stage_rc(int b, int& R, int& C) { const int st = b / 1024, sb = b % 1024, swz = sb ^ (((sb >> 9) & 1) << 5); R = (st >> 1) * 16 + swz / 64; C = (st & 1) * 32 + (swz % 64) / 2; }
__device__ __forceinline__ int perm32(int rho) { const int n = rho >> 4, i = rho & 15; return 8 * (i >> 2) + 4 * n + (i & 3); }
struct Unit { int pm, pn, z, grow; const char* a; const char* b; };
struct Gemm { int lda, ldb, K; const PG8_LAS int* gtab; };
struct Order {
    int nM, nN, nwg, G, c;
    __device__ void init(int nM_, int nN_, int G_, int c_) { nM = nM_; nN = nN_; nwg = nM * nN; G = G_; c = c_; }
    __device__ bool tile(int i, int& pm, int& pn) const {
        const long L = (long)i * G + c; if (L >= nwg) return false;
        int wgid = (int)L; { const int q = nwg / NXCD, r = nwg % NXCD, xcd = wgid % NXCD, off = wgid / NXCD; wgid = (xcd < r ? xcd * (q + 1) : r * (q + 1) + (xcd - r) * q) + off; }
        const int nig = WGM * nN, gid = wgid / nig, fm = gid * WGM, gsz = (nM - fm) < WGM ? (nM - fm) : WGM;
        pm = fm + ((wgid % nig) % gsz); pn = (wgid % nig) / gsz; return true;
    }
};
typedef float f32x2c __attribute__((ext_vector_type(2))); typedef __bf16 bf16x2c __attribute__((ext_vector_type(2)));
__device__ __forceinline__ unsigned pk2f(float a, float b) { const f32x2c v = {a, b}; return __builtin_bit_cast(unsigned, __builtin_convertvector(v, bf16x2c)); }
__device__ __forceinline__ unsigned cvt_pk_bf16(float lo, float hi) { unsigned r; asm volatile("v_cvt_pk_bf16_f32 %0, %1, %2" : "=v"(r) : "v"(lo), "v"(hi)); return r; }

template <class Epi, class Sched, bool GATHER = false>
__device__ __forceinline__ void gemm_phase(PG8_LAS unsigned char* lds, const Gemm g, const Sched& S, const Epi& E) {
    const int tid = opq((int)threadIdx.x), wid = __builtin_amdgcn_readfirstlane(tid >> 6), lane = tid & 63, wr = wid >> 2, wc = wid & 3, fr = lane & 15, fq = lane >> 4;
    const int K = g.K, nt = K / BK;
    unsigned voffA[2], voffB[2]; int Rr[2], Cc[2];
#pragma unroll
    for (int i = 0; i < 2; ++i) { int R, C; stage_rc(tid * 16 + i * 8192, R, C); const int Rb = Epi::PERM ? ((R & ~31) + perm32(R & 31)) : R; Rr[i] = R; Cc[i] = C;
        voffA[i] = (unsigned)(R * g.lda + C) * 2u; voffB[i] = (unsigned)(Rb * g.ldb + C) * 2u; }
    const size_t kstep = (size_t)(BK * 2);
    const size_t hstepA = GATHER ? 0 : (size_t)HALF * g.lda * 2, hstepB = (size_t)HALF * g.ldb * 2;
    const unsigned ldsw = (unsigned)wid * 1024u;
    const int aoff = lds_byte(wr * 64 + fr, fq * 8), boff = lds_byte(wc * 32 + fr, fq * 8);
    unsigned vC[2][2], vN[2][2];
#define PG8_GOFF(dst, ord) do { _Pragma("unroll") for (int _h = 0; _h < 2; ++_h) _Pragma("unroll") for (int _i = 0; _i < 2; ++_i) \
        dst[_h][_i] = ((unsigned)g.gtab[(ord) * BM + _h * HALF + Rr[_i]] * (unsigned)g.lda + (unsigned)Cc[_i]) * 2u; } while (0)
#define PG8_SA(b, h) (((b) * 2 + (h)) * HTB)
#define PG8_SB(b, h) ((4 + (b) * 2 + (h)) * HTB)
#define PG8_STAGE(bufoff, gbase, voff) do { _Pragma("unroll") for (int _i = 0; _i < 2; ++_i) \
        __builtin_amdgcn_global_load_lds((const unsigned*)((const char*)(gbase) + (voff)[_i]), (PG8_LAS unsigned*)(lds + (bufoff) + ldsw + _i * 8192), 16, 0, 0); } while (0)
#define PG8_STAGE_A(bufoff, kptr, h, nx) do { if constexpr (GATHER) { _Pragma("unroll") for (int _i = 0; _i < 2; ++_i) { const unsigned _o = (nx) ? vN[h][_i] : vC[h][_i]; \
            __builtin_amdgcn_global_load_lds((const unsigned*)((const char*)(kptr) + _o), (PG8_LAS unsigned*)(lds + (bufoff) + ldsw + _i * 8192), 16, 0, 0); } } \
        else PG8_STAGE(bufoff, (kptr) + (h) * hstepA, voffA); } while (0)
#define PG8_LDA(dst, b, h) do { _Pragma("unroll") for (int m = 0; m < 4; ++m) _Pragma("unroll") for (int k = 0; k < 2; ++k) dst[m][k] = *(const PG8_LAS bf16x8*)(lds + PG8_SA(b, h) + aoff + m * 2048 + k * 1024); } while (0)
#define PG8_LDB(dst, b, h) do { _Pragma("unroll") for (int n = 0; n < 2; ++n) _Pragma("unroll") for (int k = 0; k < 2; ++k) dst[n][k] = *(const PG8_LAS bf16x8*)(lds + PG8_SB(b, h) + boff + n * 2048 + k * 1024); } while (0)
#define PG8_MMA(ai, bj, At, Bt) do { __builtin_amdgcn_s_setprio(1); _Pragma("unroll") for (int m = 0; m < 4; ++m) _Pragma("unroll") for (int n = 0; n < 2; ++n) _Pragma("unroll") for (int k = 0; k < 2; ++k) \
        acc[ai][bj][m][n] = __builtin_amdgcn_mfma_f32_16x16x32_bf16(Bt[n][k], At[m][k], acc[ai][bj][m][n], 0, 0, 0); __builtin_amdgcn_s_setprio(0); } while (0)
#define PG8_WAIT_V(n) asm volatile("s_waitcnt vmcnt(" #n ")" ::: "memory")
#define PG8_WAIT_L(n) asm volatile("s_waitcnt lgkmcnt(" #n ")" ::: "memory")
#define PG8_BAR __builtin_amdgcn_s_barrier()
#define PG8_SCHED __builtin_amdgcn_sched_barrier(0)
    Unit cur, nxt; int ui = 0;
    if (!S.next(0, cur)) return;
    f32x4 acc[2][2][4][2];
    { const float z = zero_f();
#pragma unroll
    for (int a = 0; a < 2; ++a)
#pragma unroll
        for (int b = 0; b < 2; ++b)
#pragma unroll
            for (int m = 0; m < 4; ++m)
#pragma unroll
                for (int n = 0; n < 2; ++n) acc[a][b][m][n] = (f32x4){z, z, z, z}; }
    bf16x8 At[4][2], B0[2][2], B1[2][2];
    const char* cA = cur.a; const char* cB = cur.b;
    if constexpr (GATHER) { PG8_GOFF(vC, 0); }
    PG8_STAGE(PG8_SB(0, 0), cB, voffB); PG8_STAGE(PG8_SB(0, 1), cB + hstepB, voffB); PG8_STAGE_A(PG8_SA(0, 0), cA, 0, false); PG8_STAGE_A(PG8_SA(0, 1), cA, 1, false);
    if (wr == 1) PG8_BAR;
    PG8_WAIT_V(2); PG8_BAR;
    PG8_STAGE(PG8_SB(1, 0), cB + kstep, voffB); PG8_STAGE_A(PG8_SA(1, 0), cA + kstep, 0, false); PG8_STAGE(PG8_SB(1, 1), cB + hstepB + kstep, voffB);
    PG8_WAIT_V(6); PG8_BAR;
    for (;;) {
        const bool has_next = S.next(ui + 1, nxt);
        const char* nA = has_next ? nxt.a : cA; const char* nB = has_next ? nxt.b : cB;
        if constexpr (GATHER) { if (has_next) { PG8_GOFF(vN, ui + 1); } else {
#pragma unroll
            for (int h = 0; h < 2; ++h)
#pragma unroll
                for (int i = 0; i < 2; ++i) vN[h][i] = vC[h][i]; } }
#pragma unroll 1
        for (int t = 0; t < nt; t += 2) {
            const bool last = (t == nt - 2);
            const char* a1 = cA + (size_t)(t + 1) * kstep;
            const char* a2 = last ? nA : cA + (size_t)(t + 2) * kstep; const char* b2 = last ? nB : cB + (size_t)(t + 2) * kstep;
            const char* a3 = a2 + kstep; const char* b3 = b2 + kstep;
            PG8_LDB(B0, 0, 0); PG8_LDB(B1, 0, 1); PG8_SCHED; PG8_LDA(At, 0, 0); PG8_STAGE_A(PG8_SA(1, 1), a1, 1, false);
            PG8_WAIT_V(8); PG8_WAIT_L(0); PG8_BAR; PG8_MMA(0, 0, At, B0); PG8_MMA(0, 1, At, B1); PG8_BAR; PG8_SCHED;
            PG8_LDA(At, 0, 1); PG8_STAGE(PG8_SB(0, 0), b2, voffB); PG8_STAGE(PG8_SB(0, 1), b2 + hstepB, voffB); PG8_STAGE_A(PG8_SA(0, 0), a2, 0, last);
            PG8_WAIT_V(8); PG8_WAIT_L(0); PG8_BAR; PG8_MMA(1, 0, At, B0); PG8_MMA(1, 1, At, B1); PG8_BAR; PG8_SCHED;
            PG8_LDB(B0, 1, 0); PG8_LDB(B1, 1, 1); PG8_SCHED; PG8_LDA(At, 1, 0); PG8_STAGE_A(PG8_SA(0, 1), a2, 1, last);
            PG8_WAIT_V(8); PG8_WAIT_L(0); PG8_BAR; PG8_MMA(0, 0, At, B0); PG8_MMA(0, 1, At, B1); PG8_BAR; PG8_SCHED;
            PG8_LDA(At, 1, 1); PG8_STAGE(PG8_SB(1, 0), b3, voffB); PG8_STAGE(PG8_SB(1, 1), b3 + hstepB, voffB); PG8_STAGE_A(PG8_SA(1, 0), a3, 0, last);
            PG8_WAIT_V(8); PG8_WAIT_L(0); PG8_BAR; PG8_MMA(1, 0, At, B0); PG8_MMA(1, 1, At, B1); PG8_BAR; PG8_SCHED;
        }
        if (wr == 0) PG8_BAR;
        E(acc, cur, wr, wc, fr, fq);
        if (!has_next) break;
        if (!E.keep(cur)) { const float z = zero_f();
#pragma unroll
        for (int a = 0; a < 2; ++a)
#pragma unroll
            for (int b = 0; b < 2; ++b)
#pragma unroll
                for (int m = 0; m < 4; ++m)
#pragma unroll
                    for (int n = 0; n < 2; ++n) acc[a][b][m][n] = (f32x4){z, z, z, z};
        }
        cur = nxt; cA = nA; cB = nB; ++ui;
        if constexpr (GATHER) {
#pragma unroll
            for (int h = 0; h < 2; ++h)
#pragma unroll
                for (int i = 0; i < 2; ++i) vC[h][i] = vN[h][i]; }
        if (wr == 1) PG8_BAR;
    }
    PG8_WAIT_V(0);
    PG8_BAR;
#undef PG8_GOFF
#undef PG8_SA
#undef PG8_SB
#undef PG8_STAGE
#undef PG8_STAGE_A
#undef PG8_LDA
#undef PG8_LDB
#undef PG8_MMA
#undef PG8_WAIT_V
#undef PG8_WAIT_L
#undef PG8_BAR
#undef PG8_SCHED
}
}
using pg8::f32x4; using pg8::u32x4; using pg8::u32x2; using pg8::Unit; using pg8::cvt_pk_bf16;
#define LAS __attribute__((address_space(3)))
__device__ __forceinline__ f32x4 bf4(u32x2 w) { f32x4 r; r[0] = __uint_as_float(w.x << 16); r[1] = __uint_as_float(w.x & 0xffff0000u); r[2] = __uint_as_float(w.y << 16); r[3] = __uint_as_float(w.y & 0xffff0000u); return r; }

struct SchedPlain : pg8::Order { const char* A; const char* B; size_t sa, sb;
    __device__ bool next(int i, Unit& u) const { if (!tile(i, u.pm, u.pn)) return false; u.z = 0; u.grow = 0; u.a = A + (size_t)u.pm * sa; u.b = B + (size_t)u.pn * sb; return true; } };
struct SchedBranch : pg8::Order { const char* A; const char* B;
    __device__ bool next(int i, Unit& u) const { if (!tile(i / NBR, u.pm, u.pn)) return false; u.z = i % NBR; u.grow = 0;
        u.a = A + ((size_t)u.pm * 256 * (NBR * BW) + (size_t)u.z * BW) * 2; u.b = B + ((size_t)u.z * D * BW + (size_t)u.pn * 256 * BW) * 2; return true; } };
struct SchedExpert : pg8::Order { const char* A; const char* B; size_t sa, sb, sbz; int tpe;
    __device__ bool next(int i, Unit& u) const { if (!tile(i, u.pm, u.pn)) return false; u.z = u.pm / tpe; u.pm = u.z * (ME / 256) + u.pm % tpe; u.grow = u.pm * 256; u.a = A + (size_t)u.pm * sa; u.b = B + (size_t)u.z * sbz + (size_t)u.pn * sb; return true; } };

struct EpiStoreBf16 {
    static constexpr bool PERM = true; bf16_t* O; int ldc;
    __device__ __forceinline__ bool keep(const Unit&) const { return false; }
    __device__ __forceinline__ void operator()(const f32x4 (&acc)[2][2][4][2], const Unit& u, int wr, int wc, int fr, int fq) const {
        const int row0 = u.pm * 256 + wr * 64 + fr, col0 = u.pn * 256 + wc * 32 + 8 * fq;
#pragma unroll
        for (int ai = 0; ai < 2; ++ai)
#pragma unroll
            for (int m = 0; m < 4; ++m) { bf16_t* rowp = O + (size_t)(row0 + ai * 128 + m * 16) * ldc + col0;
#pragma unroll
                for (int bj = 0; bj < 2; ++bj) { const f32x4 v0 = acc[ai][bj][m][0], v1 = acc[ai][bj][m][1];
                    u32x4 w; w.x = cvt_pk_bf16(v0[0], v0[1]); w.y = cvt_pk_bf16(v0[2], v0[3]); w.z = cvt_pk_bf16(v1[0], v1[1]); w.w = cvt_pk_bf16(v1[2], v1[3]);
                    *(u32x4*)(rowp + bj * 128) = w; } }
    }
};
struct EpiInProj {
    static constexpr bool PERM = true; bf16_t* O;
    __device__ __forceinline__ bool keep(const Unit&) const { return false; }
    __device__ __forceinline__ void operator()(const f32x4 (&acc)[2][2][4][2], const Unit& u, int wr, int wc, int fr, int fq) const {
        const int row0 = u.pm * 256 + wr * 64 + fr, col0 = u.pn * 256 + wc * 32 + 8 * fq; const bool gates = u.pn * 256 + 256 > C_G;
#pragma unroll
        for (int ai = 0; ai < 2; ++ai)
#pragma unroll
            for (int m = 0; m < 4; ++m) { bf16_t* rowp = O + (size_t)(row0 + ai * 128 + m * 16) * LDP + col0;
#pragma unroll
                for (int bj = 0; bj < 2; ++bj) { f32x4 v0 = acc[ai][bj][m][0], v1 = acc[ai][bj][m][1];
                    if (gates && col0 + bj * 128 >= C_G) {
#pragma unroll
                        for (int e = 0; e < 4; ++e) { v0[e] = sigmoidf_(fminf(fmaxf(v0[e], -30.f), 30.f)); v1[e] = sigmoidf_(fminf(fmaxf(v1[e], -30.f), 30.f)); } }
                    u32x4 w; w.x = cvt_pk_bf16(v0[0], v0[1]); w.y = cvt_pk_bf16(v0[2], v0[3]); w.z = cvt_pk_bf16(v1[0], v1[1]); w.w = cvt_pk_bf16(v1[2], v1[3]);
                    *(u32x4*)(rowp + bj * 128) = w; } }
    }
};
struct EpiBranch {
    static constexpr bool PERM = true; bf16_t* MIXb; const bf16_t* Pb;
    __device__ __forceinline__ bool keep(const Unit& u) const { return u.z < NBR - 1; }
    __device__ __forceinline__ void operator()(f32x4 (&acc)[2][2][4][2], const Unit& u, int wr, int wc, int fr, int fq) const {
        const int row0 = u.pm * 256 + wr * 64 + fr, col0 = u.pn * 256 + wc * 32 + 8 * fq; const bool mid = u.z < NBR - 1;
#pragma unroll
        for (int ai = 0; ai < 2; ++ai) {
            u32x4 g[4][2], h[4][2];
#pragma unroll
            for (int m = 0; m < 4; ++m)
#pragma unroll
                for (int bj = 0; bj < 2; ++bj) { const bf16_t* gp = Pb + (size_t)(row0 + ai * 128 + m * 16) * LDP + C_G + u.z * D + col0 + bj * 128; g[m][bj] = *(const u32x4*)gp; h[m][bj] = *(const u32x4*)(gp + (mid ? D : 0)); }
            __builtin_amdgcn_sched_barrier(0);
#pragma unroll
            for (int m = 0; m < 4; ++m)
#pragma unroll
                for (int bj = 0; bj < 2; ++bj) { f32x4 s0 = bf4((u32x2){g[m][bj].x, g[m][bj].y}), s1 = bf4((u32x2){g[m][bj].z, g[m][bj].w});
                    if (mid) { const f32x4 d0 = bf4((u32x2){h[m][bj].x, h[m][bj].y}), d1 = bf4((u32x2){h[m][bj].z, h[m][bj].w});
#pragma unroll
                        for (int e = 0; e < 4; ++e) { s0[e] *= __builtin_amdgcn_rcpf(d0[e]); s1[e] *= __builtin_amdgcn_rcpf(d1[e]); } }
                    acc[ai][bj][m][0] *= s0; acc[ai][bj][m][1] *= s1; }
            if (!mid) {
#pragma unroll
                for (int m = 0; m < 4; ++m)
#pragma unroll
                    for (int bj = 0; bj < 2; ++bj) { const f32x4 v0 = acc[ai][bj][m][0], v1 = acc[ai][bj][m][1];
                        *(u32x4*)(MIXb + (size_t)(row0 + ai * 128 + m * 16) * D + col0 + bj * 128) = (u32x4){cvt_pk_bf16(v0[0], v0[1]), cvt_pk_bf16(v0[2], v0[3]), cvt_pk_bf16(v1[0], v1[1]), cvt_pk_bf16(v1[2], v1[3])}; } }
        }
    }
};
struct EpiOut {
    static constexpr bool PERM = false; float* X; const float* mod;
    __device__ __forceinline__ bool keep(const Unit&) const { return false; }
    __device__ __forceinline__ void operator()(const f32x4 (&acc)[2][2][4][2], const Unit& u, int wr, int wc, int fr, int fq) const {
        const int row0 = u.pm * 256 + wr * 64 + fr, col0 = u.pn * 256 + wc * 32 + 4 * fq;
        const int rt = u.pm * 256; const int ci = rt < BX ? rt / SEQ : BATCH;
        const float* g1 = mod + (size_t)ci * 6 * D + 2 * D;
        f32x4 gv[2][2];
#pragma unroll
        for (int bj = 0; bj < 2; ++bj)
#pragma unroll
            for (int n = 0; n < 2; ++n) gv[bj][n] = *(const f32x4*)(g1 + col0 + bj * 128 + n * 16);
#pragma unroll
        for (int ai = 0; ai < 2; ++ai) {
            f32x4 xv[4][2][2];
#pragma unroll
            for (int m = 0; m < 4; ++m)
#pragma unroll
                for (int bj = 0; bj < 2; ++bj)
#pragma unroll
                    for (int n = 0; n < 2; ++n) xv[m][bj][n] = *(const f32x4*)(X + (size_t)(row0 + ai * 128 + m * 16) * D + col0 + bj * 128 + n * 16);
            __builtin_amdgcn_sched_barrier(0);
#pragma unroll
            for (int m = 0; m < 4; ++m)
#pragma unroll
                for (int bj = 0; bj < 2; ++bj)
#pragma unroll
                    for (int n = 0; n < 2; ++n) *(f32x4*)(X + (size_t)(row0 + ai * 128 + m * 16) * D + col0 + bj * 128 + n * 16) = xv[m][bj][n] + gv[bj][n] * acc[ai][bj][m][n];
        }
    }
};
struct SchedBrCtx { int wg; const char* A; const char* B;
    __device__ bool next(int i, Unit& u) const { if (i > 0 || wg >= (BC / 256) * (D / 256) * NBR * 2) return false; const int t = wg / (NBR * 2), rem = wg % (NBR * 2); u.z = rem >> 1; u.grow = rem & 1;
        u.pm = BX / 256 + t / (D / 256); u.pn = t % (D / 256);
        u.a = A + ((size_t)u.pm * 256 * (NBR * BW) + (size_t)u.z * BW + (size_t)u.grow * (BW / 2)) * 2; u.b = B + ((size_t)u.z * D * BW + (size_t)u.pn * 256 * BW + (size_t)u.grow * (BW / 2)) * 2; return true; } };
struct EpiBrCtx {
    static constexpr bool PERM = true; bf16_t* BP; const bf16_t* Pb;
    __device__ __forceinline__ bool keep(const Unit&) const { return false; }
    __device__ __forceinline__ void operator()(const f32x4 (&acc)[2][2][4][2], const Unit& u, int wr, int wc, int fr, int fq) const {
        const int row0 = u.pm * 256 + wr * 64 + fr, col0 = u.pn * 256 + wc * 32 + 8 * fq; bf16_t* O = BP + (size_t)(u.z * 2 + u.grow) * BC * D;
        u32x4 g[2][4][2];
#pragma unroll
        for (int ai = 0; ai < 2; ++ai)
#pragma unroll
            for (int m = 0; m < 4; ++m)
#pragma unroll
                for (int bj = 0; bj < 2; ++bj) g[ai][m][bj] = *(const u32x4*)(Pb + (size_t)(row0 + ai * 128 + m * 16) * LDP + C_G + u.z * D + col0 + bj * 128);
        __builtin_amdgcn_sched_barrier(0);
#pragma unroll
        for (int ai = 0; ai < 2; ++ai)
#pragma unroll
            for (int m = 0; m < 4; ++m) { const size_t row = (size_t)(row0 + ai * 128 + m * 16);
#pragma unroll
                for (int bj = 0; bj < 2; ++bj) { const int col = col0 + bj * 128; const u32x4 gg = g[ai][m][bj];
                    const f32x4 v0 = acc[ai][bj][m][0] * bf4((u32x2){gg.x, gg.y}), v1 = acc[ai][bj][m][1] * bf4((u32x2){gg.z, gg.w});
                    *(u32x4*)(O + (row - BX) * D + col) = (u32x4){cvt_pk_bf16(v0[0], v0[1]), cvt_pk_bf16(v0[2], v0[3]), cvt_pk_bf16(v1[0], v1[1]), cvt_pk_bf16(v1[2], v1[3])}; } }
    }
};
struct SchedOutCtx { int wg; const char* A; const char* B;
    __device__ bool next(int i, Unit& u) const { if (i > 0 || wg >= (BC / 256) * (D / 256) * 2 * NBR) return false; const int t = wg / (2 * NBR); u.grow = wg % (2 * NBR); u.z = 0;
        u.pm = BX / 256 + t / (D / 256); u.pn = t % (D / 256);
        u.a = A + ((size_t)u.grow * BC * D + (size_t)(u.pm * 256 - BX) * D) * 2; u.b = B + (size_t)u.pn * 256 * D * 2; return true; } };
struct EpiOutCtx {
    static constexpr bool PERM = true; bf16_t* OP;
    __device__ __forceinline__ bool keep(const Unit&) const { return false; }
    __device__ __forceinline__ void operator()(const f32x4 (&acc)[2][2][4][2], const Unit& u, int wr, int wc, int fr, int fq) const {
        const int row0 = u.pm * 256 + wr * 64 + fr - BX, col0 = u.pn * 256 + wc * 32 + 8 * fq; bf16_t* O = OP + (size_t)u.grow * BC * D;
#pragma unroll
        for (int ai = 0; ai < 2; ++ai)
#pragma unroll
            for (int m = 0; m < 4; ++m) { bf16_t* rowp = O + (size_t)(row0 + ai * 128 + m * 16) * D + col0;
#pragma unroll
                for (int bj = 0; bj < 2; ++bj) { const f32x4 v0 = acc[ai][bj][m][0], v1 = acc[ai][bj][m][1];
                    u32x4 w; w.x = cvt_pk_bf16(v0[0], v0[1]); w.y = cvt_pk_bf16(v0[2], v0[3]); w.z = cvt_pk_bf16(v1[0], v1[1]); w.w = cvt_pk_bf16(v1[2], v1[3]);
                    *(u32x4*)(rowp + bj * 128) = w; } }
    }
};
struct EpiSwiglu {
    static constexpr bool PERM = true; bf16_t* H;
    __device__ __forceinline__ bool keep(const Unit&) const { return false; }
    __device__ __forceinline__ void operator()(const f32x4 (&acc)[2][2][4][2], const Unit& u, int wr, int wc, int fr, int fq) const {
        const int row0 = u.pm * 256 + wr * 64 + fr, col0 = u.pn * 128 + wc * 32 + 8 * fq;
#pragma unroll
        for (int ai = 0; ai < 2; ++ai)
#pragma unroll
            for (int m = 0; m < 4; ++m) { bf16_t* rowp = H + (size_t)(row0 + ai * 128 + m * 16) * EH + col0;
                f32x4 h0, h1;
#pragma unroll
                for (int j = 0; j < 4; ++j) { h0[j] = siluf_(acc[ai][0][m][0][j]) * acc[ai][1][m][0][j]; h1[j] = siluf_(acc[ai][0][m][1][j]) * acc[ai][1][m][1][j]; }
                u32x4 w; w.x = cvt_pk_bf16(h0[0], h0[1]); w.y = cvt_pk_bf16(h0[2], h0[3]); w.z = cvt_pk_bf16(h1[0], h1[1]); w.w = cvt_pk_bf16(h1[2], h1[3]);
                *(u32x4*)rowp = w; }
    }
};

__device__ __forceinline__ void cvt_tile_wave(const float* src, int N, int k0, int n0, bf16_t* dst, int ldd, int rowmode, LAS float* tile, int lane) {
    { const int kk = lane >> 4, n4 = (lane & 15) * 4; const bool ok = n0 + n4 < N; const float* sp = src + (size_t)(k0 + kk) * N + (ok ? n0 + n4 : 0);
      f32x4 v[16];
#pragma unroll
      for (int j = 0; j < 16; ++j) v[j] = *(const f32x4*)(sp + (size_t)(4 * j) * N);
      __builtin_amdgcn_sched_barrier(0);
#pragma unroll
      for (int j = 0; j < 16; ++j) { LAS float* tp = tile + (kk + 4 * j) * 65 + n4; tp[0] = ok ? v[j][0] : 0.f; tp[1] = ok ? v[j][1] : 0.f; tp[2] = ok ? v[j][2] : 0.f; tp[3] = ok ? v[j][3] : 0.f; } }
    { const int nl = lane >> 3, k8 = (lane & 7) * 8;
#pragma unroll
      for (int hf = 0; hf < 2; ++hf) { float tv[4][8];
#pragma unroll
          for (int q = 0; q < 4; ++q) { const LAS float* tp = tile + k8 * 65 + (hf * 4 + q) * 8 + nl;
#pragma unroll
              for (int e = 0; e < 8; ++e) tv[q][e] = tp[e * 65]; }
          __builtin_amdgcn_sched_barrier(0);
#pragma unroll
          for (int q = 0; q < 4; ++q) { const int n = (hf * 4 + q) * 8 + nl, ng = n0 + n;
              if (ng < N) { const int row = rowmode == 0 ? ng : (ng >> 7) * 256 + (rowmode == 2 ? 128 : 0) + (ng & 127);
                  *(u32x4*)(dst + (size_t)row * ldd + k0 + k8) = (u32x4){pg8::pk2f(tv[q][0], tv[q][1]), pg8::pk2f(tv[q][2], tv[q][3]), pg8::pk2f(tv[q][4], tv[q][5]), pg8::pk2f(tv[q][6], tv[q][7])}; } } } }
}
constexpr int CT_IN = (D / 64) * ((D_IN + 63) / 64), CT_BR = NBR * (BW / 64) * (D / 64), CT_OUT = (D / 64) * (D / 64), CT_GU = 2 * NE * (D / 64) * (EH / 64), CT_D = NE * (EH / 64) * (D / 64), CT_ALL = CT_IN + CT_BR + CT_OUT + CT_GU + CT_D;
__device__ __forceinline__ void cvt_weights_wave(const Ptrs& p, int l, LAS float* tile, int tbeg, int tend, int gw, int nw, int lane) {
#pragma unroll 1
    for (int t = tbeg + gw; t < tend; t += nw) {
        if (t < CT_IN) { const int nk = D / 64; cvt_tile_wave(p.w_in + (size_t)l * D * D_IN, D_IN, (t % nk) * 64, (t / nk) * 64, p.Wt_in_(), D, 0, tile, lane); }
        else if (t < CT_IN + CT_BR) { const int u = t - CT_IN, nk = BW / 64, per = nk * (D / 64), z = u / per, v = u % per;
            cvt_tile_wave(p.w_branch + ((size_t)l * NBR + z) * BW * D, D, (v % nk) * 64, (v / nk) * 64, p.Wt_br_() + (size_t)z * D * BW, BW, 0, tile, lane); }
        else if (t < CT_IN + CT_BR + CT_OUT) { const int u = t - CT_IN - CT_BR, nk = D / 64; cvt_tile_wave(p.w_out + (size_t)l * D * D, D, (u % nk) * 64, (u / nk) * 64, p.Wt_out_(), D, 0, tile, lane); }
        else if (t < CT_IN + CT_BR + CT_OUT + CT_GU) { const int u = t - CT_IN - CT_BR - CT_OUT, nk = D / 64, per = nk * (EH / 64), which = u / (NE * per), e = (u / per) % NE, v = u % per;
            cvt_tile_wave((which ? p.w_exp_up : p.w_exp_gate) + ((size_t)l * NE + e) * D * EH, EH, (v % nk) * 64, (v / nk) * 64, p.Wt_gu_() + (size_t)e * 2 * EH * D, D, 1 + which, tile, lane); }
        else { const int u = t - CT_IN - CT_BR - CT_OUT - CT_GU, nk = EH / 64, per = nk * (D / 64), e = u / per, v = u % per;
            cvt_tile_wave(p.w_exp_down + ((size_t)l * NE + e) * EH * D, D, (v % nk) * 64, (v / nk) * 64, p.Wt_d_() + (size_t)e * D * EH, EH, 0, tile, lane); }
    }
}
constexpr int CF_DOWN = (NWG - 64) * 8 * 6, CF_OUT = (NWG - 192) * 8 * 6, CF_ALL = CF_DOWN + CF_OUT;
static_assert(CF_ALL < CT_ALL && NE * (ME / 256) * (D / 256) - 2 * NWG == 64 && (BC / 256) * (D / 256) * 2 * NBR == 192, "filler shares follow the unit counts");
__device__ __forceinline__ void cvt_weights_small(const Ptrs& p, int l, int G, int wg) {
    const int nz = (LDP - D_IN) * D / 8;
#pragma unroll 1
    for (int i = wg * 512 + opq((int)threadIdx.x); i < nz; i += G * 512) { const unsigned z = __float_as_uint(zero_f()); *(u32x4*)(p.Wt_in_() + (size_t)D_IN * D + (size_t)i * 8) = (u32x4){z, z, z, z}; }
#pragma unroll 1
    for (int i = wg * 512 + opq((int)threadIdx.x); i < 4 * LB * LBW * LBW; i += G * 512) { const int ii = i % LBW, j = (i / LBW) % LBW, blk = i / (LBW * LBW);
        p.Wt_lg_()[i] = f2bf(p.lru_gate_w[(size_t)l * 4 * LB * LBW * LBW + ((size_t)blk * LBW + ii) * LBW + j]); }
}
__device__ __forceinline__ void phase_gemm_in(const Ptrs& p, LAS unsigned char* lds, int G, int wg) {
    SchedPlain S; S.init(NR / 256, LDP / 256, G, wg); S.A = (const char*)p.HXb_(); S.B = (const char*)p.Wt_in_(); S.sa = (size_t)256 * D * 2; S.sb = (size_t)256 * D * 2;
    pg8::gemm_phase(lds, pg8::Gemm{D, D, D, nullptr}, S, EpiInProj{p.Pb_()});
}
__device__ __forceinline__ void phase_gemm_branch(const Ptrs& p, LAS unsigned char* lds, int G, int wg, bool xonly) {
    SchedBranch S; S.init(BX / 256, D / 256, G, wg); S.A = (const char*)p.BRb_(); S.B = (const char*)p.Wt_br_();
    pg8::gemm_phase(lds, pg8::Gemm{NBR * BW, BW, BW, nullptr}, S, EpiBranch{p.MIXb_(), p.Pb_()});
    if (!xonly) { SchedBrCtx C; C.wg = wg; C.A = (const char*)p.BRb_(); C.B = (const char*)p.Wt_br_();
        pg8::gemm_phase(lds, pg8::Gemm{NBR * BW, BW, BW / 2, nullptr}, C, EpiBrCtx{p.BP_(), p.Pb_()}); }
}
__device__ __forceinline__ void phase_gemm_out(const Ptrs& p, const Ptrs& pn, int l, LAS unsigned char* lds, int G, int wg, bool xonly) {
    SchedPlain S; S.init(BX / 256, D / 256, G, wg); S.A = (const char*)p.MIXb_(); S.B = (const char*)p.Wt_out_(); S.sa = (size_t)256 * D * 2; S.sb = (size_t)256 * D * 2;
    pg8::gemm_phase(lds, pg8::Gemm{D, D, D, nullptr}, S, EpiOut{p.X_(), p.MOD_() + (size_t)l * NCOND * 6 * D});
    if (!xonly) { SchedOutCtx C; C.wg = wg; C.A = (const char*)p.BP_(); C.B = (const char*)p.Wt_out_();
        pg8::gemm_phase(lds, pg8::Gemm{D, D, D, nullptr}, C, EpiOutCtx{(bf16_t*)p.OP_()});
        if (wg >= 192) { const int tidq = opq((int)threadIdx.x), wv = tidq >> 6; cvt_weights_wave(pn, l + 1, (LAS float*)lds + wv * (64 * 65), CF_DOWN, CF_ALL, (wg - 192) * 8 + wv, (NWG - 192) * 8, tidq & 63); } }
}
__device__ __forceinline__ void phase_gemm_gu(const Ptrs& p, LAS unsigned char* lds, int G, int wg, bool xonly) {
    SchedExpert S; S.tpe = xonly ? BATCH * CAPX / 256 : ME / 256; S.init(NE * S.tpe, 2 * EH / 256, G, wg); S.A = (const char*)p.HXb_(); S.B = (const char*)p.Wt_gu_(); S.sa = 0; S.sb = (size_t)256 * D * 2; S.sbz = (size_t)2 * EH * D * 2;
    LAS int* gtab = (LAS int*)(lds + pg8::STAGE_BYTES);
    { Unit u; u.grow = 0; const int tid = opq((int)threadIdx.x); constexpr int MAXU = (NE * (ME / 256) * (2 * EH / 256) + NWG - 1) / NWG;
      int gv[MAXU]; bool gok[MAXU];
#pragma unroll
      for (int i = 0; i < MAXU; ++i) { gok[i] = S.next(i, u); gv[i] = p.IDX_()[u.grow + (tid & 255)]; }
      __builtin_amdgcn_sched_barrier(0);
#pragma unroll
      for (int i = 0; i < MAXU; ++i) if (gok[i] && tid < 256) gtab[i * 256 + tid] = gv[i]; }
    __syncthreads();
    pg8::gemm_phase<EpiSwiglu, SchedExpert, true>(lds, pg8::Gemm{D, D, D, gtab}, S, EpiSwiglu{p.HIDb_()});
}
__device__ __forceinline__ void phase_gemm_down(const Ptrs& p, const Ptrs& pn, int l, LAS unsigned char* lds, int G, int wg, bool xonly) {
    SchedExpert S; S.tpe = xonly ? BATCH * CAPX / 256 : ME / 256; S.init(NE * S.tpe, D / 256, G, wg); S.A = (const char*)p.HIDb_(); S.B = (const char*)p.Wt_d_(); S.sa = (size_t)256 * EH * 2; S.sb = (size_t)256 * EH * 2; S.sbz = (size_t)D * EH * 2;
    pg8::gemm_phase(lds, pg8::Gemm{EH, EH, EH, nullptr}, S, EpiStoreBf16{p.YSb_(), D});
    if (!xonly && wg >= 64) { const int tidq = opq((int)threadIdx.x), wv = tidq >> 6; cvt_weights_wave(pn, l + 1, (LAS float*)lds + wv * (64 * 65), 0, CF_DOWN, (wg - 64) * 8 + wv, (NWG - 64) * 8, tidq & 63); }
}

#define XB_TMO      128
#define XB_XCNT(j)  (256  + 64 * (j))
#define XB_XSUB(j)  (1280 + 64 * (j))
#define XB_XGEN(j)  (2304 + 64 * (j))
#define XB_TOP      3328
#define XB_TOPGEN   3392
#define XCD_BAR_WORDS 3456
#define XB_SPIN_CAP (1u << 18)
__device__ __forceinline__ unsigned xb_ld(unsigned* p)              { return __hip_atomic_load(p, __ATOMIC_RELAXED, __HIP_MEMORY_SCOPE_AGENT); }
__device__ __forceinline__ unsigned xb_add(unsigned* p, unsigned v) { return __hip_atomic_fetch_add(p, v, __ATOMIC_RELAXED, __HIP_MEMORY_SCOPE_AGENT); }
__device__ __forceinline__ unsigned xb_xcc_id() { return (unsigned)__builtin_amdgcn_s_getreg((3 << 11) | 20) & 0xFu; }
#define XB_SPIN(cond, bar) do { unsigned _sp = 0; while (cond) { __builtin_amdgcn_s_sleep(1); \
    if ((++_sp & 255u) == 0u) { if (xb_ld(&(bar)[XB_TMO])) break; if (_sp > XB_SPIN_CAP) { atomicAdd(&(bar)[XB_TMO], 1u); break; } } } } while (0)
struct XcdBarrier { unsigned* bar; unsigned x; volatile LAS unsigned* st; };
__device__ __forceinline__ XcdBarrier xcd_barrier_post(unsigned* bar, volatile LAS unsigned* st) {
    XcdBarrier b; b.bar = bar; b.x = xb_xcc_id(); b.st = st;
    if (threadIdx.x == 0) (void)xb_add(&bar[XB_XCNT(b.x)], 1u);
    return b;
}
__device__ __forceinline__ void xcd_barrier_complete(unsigned* bar, unsigned x, unsigned& nloc, unsigned& nx) {
    const unsigned G = NWG;
    unsigned sum, cnt, mine, sp = 0u;
    for (;;) {
        sum = 0u; cnt = 0u; mine = 0u;
#pragma unroll
        for (unsigned j = 0; j < 16; ++j) { const unsigned c = xb_ld(&bar[XB_XCNT(j)]); sum += c; cnt += (c > 0u) ? 1u : 0u; mine = (j == x) ? c : mine; }
        if (sum == G) break;
        __builtin_amdgcn_s_sleep(1);
        if ((++sp & 255u) == 0u) { if (xb_ld(&bar[XB_TMO])) break; if (sp > XB_SPIN_CAP) { atomicAdd(&bar[XB_TMO], 1u); break; } }
    }
    nloc = mine > 0u ? mine : 1u; nx = cnt > 0u ? cnt : 1u;
}
__device__ __forceinline__ void xcd_barrier(const XcdBarrier& b) {
    asm volatile("s_waitcnt vmcnt(0)" ::: "memory");
    __syncthreads();
    if (threadIdx.x == 0) {
        unsigned* bar = b.bar; unsigned bx = b.x;
        asm volatile("" : "+s"(bar), "+s"(bx));
        __builtin_amdgcn_s_waitcnt(0);
        unsigned nloc = b.st[0], nx = b.st[1];
        if (nloc == 0u) { xcd_barrier_complete(bar, bx, nloc, nx); b.st[0] = nloc; b.st[1] = nx; }
        const unsigned old = xb_add(&bar[XB_XSUB(bx)], 1u);
        const unsigned gen = old / nloc;
        if (old + 1u == (gen + 1u) * nloc) {
            __builtin_amdgcn_fence(__ATOMIC_RELEASE, "agent");
            asm volatile("s_waitcnt vmcnt(0)" ::: "memory");
            const unsigned og = xb_add(&bar[XB_TOP], 1u);
            const unsigned tg = og / nx;
            if (og + 1u == (tg + 1u) * nx) xb_add(&bar[XB_TOPGEN], 1u);
            else XB_SPIN(xb_ld(&bar[XB_TOPGEN]) == tg, bar);
            __builtin_amdgcn_fence(__ATOMIC_ACQUIRE, "agent");
            xb_add(&bar[XB_XGEN(bx)], 1u);
            asm volatile("s_waitcnt vmcnt(0)" ::: "memory");
        } else {
            XB_SPIN(xb_ld(&bar[XB_XGEN(bx)]) == gen, bar);
            __builtin_amdgcn_fence(__ATOMIC_ACQUIRE, "agent");
            asm volatile("s_waitcnt vmcnt(0)" ::: "memory");
        }
    }
    __syncthreads();
}

template <int M> __device__ __forceinline__ int shx_raw(int v, int lane) {
    if constexpr (M == 32) { const auto r = __builtin_amdgcn_permlane32_swap(v, v, false, false); return (lane & 32) ? (int)r[0] : (int)r[1]; }
    else if constexpr (M == 16) { const auto r = __builtin_amdgcn_permlane16_swap(v, v, false, false); return (lane & 16) ? (int)r[0] : (int)r[1]; }
    else if constexpr (M == 8) return __builtin_amdgcn_update_dpp(0, v, 0x128, 0xF, 0xF, true);
    else if constexpr (M == 2) return __builtin_amdgcn_update_dpp(0, v, 0x4E, 0xF, 0xF, true);
    else if constexpr (M == 1) return __builtin_amdgcn_update_dpp(0, v, 0xB1, 0xF, 0xF, true);
    else return __builtin_amdgcn_ds_swizzle(v, 0x1F | (M << 10));
}
#define shx(v, m, lane) __int_as_float(shx_raw<m>(__float_as_int(v), lane))
#define shxi(v, m, lane) shx_raw<m>(v, lane)
__device__ __forceinline__ float shup(float v, int o, int lane) { return __int_as_float(__builtin_amdgcn_ds_bpermute((lane >= o ? lane - o : lane) << 2, __float_as_int(v))); }
__device__ __forceinline__ int shupi(int v, int o, int lane) { return __builtin_amdgcn_ds_bpermute((lane >= o ? lane - o : lane) << 2, v); }
__device__ __forceinline__ float wave_sum(float v, int lane) {
    { const auto r = __builtin_amdgcn_permlane32_swap(__float_as_int(v), __float_as_int(v), false, false); v = __int_as_float(r[0]) + __int_as_float(r[1]); }
    { const auto r = __builtin_amdgcn_permlane16_swap(__float_as_int(v), __float_as_int(v), false, false); v = __int_as_float(r[0]) + __int_as_float(r[1]); }
    v += shx(v, 8, lane); v += shx(v, 4, lane); v += shx(v, 2, lane); v += shx(v, 1, lane); return v; }
template <int CTRL> __device__ __forceinline__ float dpp_mov(float x) { return __int_as_float(__builtin_amdgcn_update_dpp(0, __float_as_int(x), CTRL, 0xF, 0xF, true)); }
__device__ __forceinline__ void wave_sum16(const float (&a)[16], float (&S)[16], int lane) {
    float r1[8], r2[4], r3[2];
#pragma unroll
    for (int i = 0; i < 8; ++i) { const auto r = __builtin_amdgcn_permlane32_swap(__float_as_int(a[i]), __float_as_int(a[i + 8]), false, false); r1[i] = __int_as_float(r[0]) + __int_as_float(r[1]); }
#pragma unroll
    for (int i = 0; i < 4; ++i) { const auto r = __builtin_amdgcn_permlane16_swap(__float_as_int(r1[i]), __float_as_int(r1[i + 4]), false, false); r2[i] = __int_as_float(r[0]) + __int_as_float(r[1]); }
    const bool hi8 = lane & 8;
#pragma unroll
    for (int i = 0; i < 2; ++i) { const float keep = hi8 ? r2[i + 2] : r2[i], send = hi8 ? r2[i] : r2[i + 2]; float x = keep + dpp_mov<0x128>(send);
        x += dpp_mov<0x141>(x); x += dpp_mov<0xB1>(x); x += dpp_mov<0x4E>(x); r3[i] = x; }
#pragma unroll
    for (int j = 0; j < 16; ++j) S[j] = __int_as_float(__builtin_amdgcn_readlane(__float_as_int(r3[j & 1]), 8 * ((j >> 1) & 1) + 16 * ((j >> 2) & 1) + 32 * (j >> 3)));
}
__device__ __forceinline__ void phase_adaln(const Ptrs& p, LAS float* sl, int G, int wg) {
    LAS float* red = sl + NCOND * D;
    const int tid = opq((int)threadIdx.x), col = tid & 127, kg = tid >> 7;
    for (int i = tid; i < NCOND * D; i += NTHREADS) { const int ci = i / D, k = i % D; sl[i] = siluf_(ci < BATCH ? p.c[ci * D + k] : p.c_ctx[k]); }
    __syncthreads();
#pragma unroll 1
    for (int tile = wg; tile < DEPTH * 6 * D / 128; tile += G) { const int l = tile / (6 * D / 128), j = (tile % (6 * D / 128)) * 128 + col;
        float acc[NCOND];
#pragma unroll
        for (int ci = 0; ci < NCOND; ++ci) acc[ci] = 0.f;
        const float* wp = p.w_ada + ((size_t)l * D + kg * 256) * 6 * D + j;
#pragma unroll 4
        for (int k = 0; k < 256; ++k) { const float w = wp[(size_t)k * 6 * D];
#pragma unroll
            for (int ci = 0; ci < NCOND; ++ci) acc[ci] += sl[ci * D + kg * 256 + k] * w; }
#pragma unroll
        for (int ci = 0; ci < NCOND; ++ci) red[(kg * NCOND + ci) * 128 + col] = acc[ci];
        __syncthreads();
        if (kg == 0) { const float ba = p.b_ada[(size_t)l * 6 * D + j];
#pragma unroll
            for (int ci = 0; ci < NCOND; ++ci) p.MOD_()[((size_t)l * NCOND + ci) * 6 * D + j] = red[ci * 128 + col] + red[(NCOND + ci) * 128 + col] + red[(2 * NCOND + ci) * 128 + col] + red[(3 * NCOND + ci) * 128 + col] + ba; }
        __syncthreads();
    }
}
enum { MODE_N1 = 0, MODE_N2 = 1, MODE_FINAL = 2 };
template <int MODE, bool XONLY = false> __device__ __forceinline__ void phase_rows(const Ptrs& p, int l, LAS float* wl, int G, int wg) {
    const int tid = opq((int)threadIdx.x), lane = tid & 63, wave = tid >> 6;
    constexpr int NROWS = (MODE == MODE_FINAL || XONLY) ? BX : NR, PER = NROWS / (NWG * 8);
    static_assert(NROWS % (NWG * 8) == 0, "rows per wave");
    constexpr bool MIXED = NROWS == NR; static_assert(!MIXED || (PER == 9 && BX == NWG * 8 * 8 && BC == NWG * 8), "row split");
    const int wv_ = wg * 8 + wave, r0 = MIXED ? wv_ * 8 : wv_ * PER;
#define ROW_OF(k) ((MIXED && (k) == PER - 1) ? BX + wv_ : r0 + (k))
    const float* xsrc = (MODE == MODE_N1 && l == 0) ? nullptr : p.X_();
    f32x4 gn[4], sh[4], sc[4], g2[4];
    if constexpr (MODE != MODE_FINAL) {
#pragma unroll
        for (int j = 0; j < 4; ++j) gn[j] = *(const f32x4*)((MODE == MODE_N2 ? p.norm2_g : p.norm1_g) + (size_t)l * D + 4 * lane + 256 * j); }
    int ci_cur = -1;
    f32x4 xn[4];
#define ROWS_LOAD(dst, r) do { const float* _s = xsrc ? xsrc + (size_t)(r) * D : ((r) < BX ? p.x + (size_t)(r) * D : p.ctx + (size_t)((r) - BX) * D); \
        _Pragma("unroll") for (int j = 0; j < 4; ++j) dst[j] = *(const f32x4*)(_s + 4 * lane + 256 * j); } while (0)
    f32x4 xn2[4];
    ROWS_LOAD(xn, r0); if (PER > 1) ROWS_LOAD(xn2, ROW_OF(1));
    if constexpr (MODE == MODE_N2) {
        const float* wr = p.w_router + (size_t)l * D * NE;
        { float wv[D * NE / NTHREADS];
#pragma unroll
          for (int k = 0; k < D * NE / NTHREADS; ++k) wv[k] = wr[(size_t)(tid + (k >> 4) * NTHREADS) * NE + (k & 15)];
          __builtin_amdgcn_sched_barrier(0);
#pragma unroll
          for (int k = 0; k < D * NE / NTHREADS; ++k) wl[(k & 15) * D + tid + (k >> 4) * NTHREADS] = wv[k]; }
        __syncthreads();
    }
    constexpr bool COMBINE = MODE == MODE_FINAL || MODE == MODE_N1;
    int rk_n = 1 << 30; float af_n = 0.f;
    if (COMBINE && (MODE == MODE_FINAL || l > 0) && lane < NE) { rk_n = p.RANK_()[(size_t)r0 * NE + lane]; af_n = p.AFF_()[(size_t)r0 * NE + lane]; }
#pragma unroll 1
    for (int k = 0; k < PER; ++k) { const int r = ROW_OF(k), rnx = ROW_OF(k + 1);
        const bool isx = r < BX; const int b = isx ? r / SEQ : (r - BX) / CTX; const int ci = isx ? b : BATCH;
        f32x4 x[4];
#pragma unroll
        for (int j = 0; j < 4; ++j) x[j] = xn[j];
#pragma unroll
        for (int j = 0; j < 4; ++j) xn[j] = xn2[j];
        if (k + 2 < PER) ROWS_LOAD(xn2, ROW_OF(k + 2));
        if (ci != ci_cur) { ci_cur = ci;
            if constexpr (MODE != MODE_FINAL) { const float* md = p.MOD_() + ((size_t)l * NCOND + ci) * 6 * D + (MODE == MODE_N2 ? 3 * D : 0) + 4 * lane;
#pragma unroll
                for (int j = 0; j < 4; ++j) { sh[j] = *(const f32x4*)(md + 256 * j); sc[j] = 1.0f + *(const f32x4*)(md + D + 256 * j); } }
            if ((MODE == MODE_N1 && l > 0) || MODE == MODE_FINAL) { const int lm = MODE == MODE_FINAL ? DEPTH - 1 : l - 1;
                const float* gp = p.MOD_() + ((size_t)lm * NCOND + ci) * 6 * D + 5 * D + 4 * lane;
#pragma unroll
                for (int j = 0; j < 4; ++j) g2[j] = *(const f32x4*)(gp + 256 * j); } }
        if ((MODE == MODE_N1 && l > 0) || MODE == MODE_FINAL) {
            const int cap = isx ? CAPX : CAPC;
            const int rk = rk_n; const float af = af_n;
            if (k + 1 < PER && lane < NE) { rk_n = p.RANK_()[(size_t)rnx * NE + lane]; af_n = p.AFF_()[(size_t)rnx * NE + lane]; }
            unsigned long long m = __ballot(rk < cap);
            f32x4 acc[4];
#pragma unroll
            for (int j = 0; j < 4; ++j) { const float z = zero_f(); acc[j] = (f32x4){z, z, z, z}; }
            while (m) { const int e = __builtin_ctzll(m); m &= m - 1; const bool two = m != 0; const int e2 = two ? __builtin_ctzll(m) : e; m &= m - 1;
                const int rke = __builtin_amdgcn_readlane(rk, e), rke2 = __builtin_amdgcn_readlane(rk, e2);
                const float afe = __int_as_float(__builtin_amdgcn_readlane(__float_as_int(af), e)), afe2 = two ? __int_as_float(__builtin_amdgcn_readlane(__float_as_int(af), e2)) : 0.f;
                const int sb = isx ? b * CAPX : BATCH * CAPX + b * CAPC;
                const bf16_t* ys = p.YSb_() + ((size_t)e * ME + sb + rke) * D + 4 * lane; const bf16_t* ys2 = p.YSb_() + ((size_t)e2 * ME + sb + rke2) * D + 4 * lane;
                u32x2 y1[4], y2[4];
#pragma unroll
                for (int j = 0; j < 4; ++j) { y1[j] = *(const u32x2*)(ys + 256 * j); y2[j] = *(const u32x2*)(ys2 + 256 * j); }
#pragma unroll
                for (int j = 0; j < 4; ++j) acc[j] += afe * bf4(y1[j]) + afe2 * bf4(y2[j]); }
#pragma unroll
            for (int j = 0; j < 4; ++j) x[j] += g2[j] * acc[j];
        }
        if constexpr (MODE == MODE_N2 && !XONLY) { if (!isx) {
            const float* g1 = p.MOD_() + ((size_t)l * NCOND + ci) * 6 * D + 2 * D + 4 * lane; const bf16_t* op = (const bf16_t*)p.OP_() + (size_t)(r - BX) * D + 4 * lane;
            u32x2 pv[4][6]; f32x4 g1v[4];
#pragma unroll
            for (int j = 0; j < 4; ++j) { g1v[j] = *(const f32x4*)(g1 + 256 * j);
#pragma unroll
                for (int q = 0; q < 6; ++q) pv[j][q] = *(const u32x2*)(op + (size_t)q * BC * D + 256 * j); }
            __builtin_amdgcn_sched_barrier(0);
#pragma unroll
            for (int j = 0; j < 4; ++j) { x[j] += g1v[j] * ((bf4(pv[j][0]) + bf4(pv[j][1]) + bf4(pv[j][2])) + (bf4(pv[j][3]) + bf4(pv[j][4]) + bf4(pv[j][5])));
                *(f32x4*)(p.X_() + (size_t)r * D + 4 * lane + 256 * j) = x[j]; } } }
        if constexpr (MODE == MODE_FINAL) {
#pragma unroll
            for (int j = 0; j < 4; ++j) *(f32x4*)(p.out + (size_t)r * D + 4 * lane + 256 * j) = x[j];
        } else {
            if constexpr (MODE == MODE_N1) {
#pragma unroll
                for (int j = 0; j < 4; ++j) *(f32x4*)(p.X_() + (size_t)r * D + 4 * lane + 256 * j) = x[j]; }
            float ss = 0.f;
#pragma unroll
            for (int j = 0; j < 4; ++j) ss += x[j][0] * x[j][0] + x[j][1] * x[j][1] + x[j][2] * x[j][2] + x[j][3] * x[j][3];
            const float rs = rsqrtf(wave_sum(ss, lane) * (1.0f / D) + EPS);
            f32x4 h[4];
#pragma unroll
            for (int j = 0; j < 4; ++j) { h[j] = x[j] * rs * gn[j] * sc[j] + sh[j];
                u32x2 w; w.x = cvt_pk_bf16(h[j][0], h[j][1]); w.y = cvt_pk_bf16(h[j][2], h[j][3]); *(u32x2*)(p.HXb_() + (size_t)r * D + 4 * lane + 256 * j) = w; }
            if constexpr (MODE == MODE_N2) {
                float v16[NE];
#pragma unroll
                for (int eg = 0; eg < NE; eg += 4) { f32x4 w[4][4];
#pragma unroll
                    for (int q = 0; q < 4; ++q)
#pragma unroll
                        for (int j = 0; j < 4; ++j) w[q][j] = *(const LAS f32x4*)(wl + (eg + q) * D + 4 * lane + 256 * j);
                    __builtin_amdgcn_sched_barrier(0);
#pragma unroll
                    for (int q = 0; q < 4; ++q) { float s = 0.f;
#pragma unroll
                        for (int j = 0; j < 4; ++j) s += h[j][0] * w[q][j][0] + h[j][1] * w[q][j][1] + h[j][2] * w[q][j][2] + h[j][3] * w[q][j][3];
                        v16[eg + q] = s; } }
                float v8[8], v4[4], v2[2], v1;
#pragma unroll
                for (int i = 0; i < 8; ++i) { const auto r = __builtin_amdgcn_permlane32_swap(__float_as_int(v16[i]), __float_as_int(v16[i + 8]), false, false); v8[i] = __int_as_float(r[0]) + __int_as_float(r[1]); }
#pragma unroll
                for (int i = 0; i < 4; ++i) { const auto r = __builtin_amdgcn_permlane16_swap(__float_as_int(v8[i]), __float_as_int(v8[i + 4]), false, false); v4[i] = __int_as_float(r[0]) + __int_as_float(r[1]); }
                { const bool hi = lane & 8;
#pragma unroll
                  for (int i = 0; i < 2; ++i) { const float snd = hi ? v4[i] : v4[i + 2]; v2[i] = (hi ? v4[i + 2] : v4[i]) + shx(snd, 8, lane); } }
                { const bool hi = lane & 4; const float snd = hi ? v2[0] : v2[1]; v1 = (hi ? v2[1] : v2[0]) + shx(snd, 4, lane); }
                v1 += shx(v1, 2, lane); v1 += shx(v1, 1, lane);
                float mx = v1; mx = fmaxf(mx, shx(mx, 4, lane)); mx = fmaxf(mx, shx(mx, 8, lane)); mx = fmaxf(mx, shx(mx, 16, lane)); mx = fmaxf(mx, shx(mx, 32, lane));
                const float ex = fexp(v1 - mx); float den = ex; den += shx(den, 4, lane); den += shx(den, 8, lane); den += shx(den, 16, lane); den += shx(den, 32, lane);
                const int e = ((lane >> 5) & 1) * 8 + ((lane >> 4) & 1) * 4 + ((lane >> 3) & 1) * 2 + ((lane >> 2) & 1);
                if ((lane & 3) == 0) p.AFF_()[(size_t)r * NE + e] = ex / den;
            }
        }
    }
#undef ROWS_LOAD
#undef ROW_OF
}
__device__ __forceinline__ int wave_isum(int v, int lane) { v += shxi(v, 32, lane); v += shxi(v, 16, lane); v += shxi(v, 8, lane); v += shxi(v, 4, lane); v += shxi(v, 2, lane); v += shxi(v, 1, lane); return v; }
__device__ __forceinline__ int block_excl_scan(int local, LAS unsigned* wsum, int lane, int wave) {
    int inc = local;
#pragma unroll
    for (int o = 1; o < 64; o <<= 1) { const int t = shupi(inc, o, lane); if (lane >= o) inc += t; }
    if (lane == 63) wsum[wave] = (unsigned)inc;
    __syncthreads();
    int off = 0;
#pragma unroll
    for (int w = 0; w < NTHREADS / 64; ++w) off += w < wave ? (int)wsum[w] : 0;
    __syncthreads();
    return off + inc - local;
}
__device__ __forceinline__ void phase_rank(const Ptrs& p, LAS unsigned* sh, int G, int wg, bool xonly) {
    const int tid = opq((int)threadIdx.x), lane = tid & 63, wave = tid >> 6;
#pragma unroll 1
    for (int u = wg; u < (xonly ? 1 : 2) * BATCH * NE; u += G) {
        const bool isx = u < BATCH * NE; const int v = isx ? u : u - BATCH * NE, b = v / NE, e = v % NE, T = isx ? SEQ : CTX, base = isx ? b * SEQ : BX + b * CTX, cap = isx ? CAPX : CAPC;
        unsigned key[4]; bool valid[4];
#pragma unroll
        for (int k = 0; k < 4; ++k) { const int t = 4 * tid + k; valid[k] = t < T; key[k] = valid[k] ? __float_as_uint(p.AFF_()[(size_t)(base + t) * NE + e]) : 0u; }
        if (tid < 64) sh[tid] = 0u;
        __syncthreads();
        unsigned thr = 0u;
#define RANK_CNT(cnd) (__builtin_popcountll(__ballot(key[0] >= (cnd))) + __builtin_popcountll(__ballot(key[1] >= (cnd))) + __builtin_popcountll(__ballot(key[2] >= (cnd))) + __builtin_popcountll(__ballot(key[3] >= (cnd))))
#pragma unroll 1
        for (int st = 0; st < 16; ++st) { const unsigned bhi = st < 15 ? 1u << (30 - 2 * st) : 1u, blo = st < 15 ? 1u << (29 - 2 * st) : 0u;
            const unsigned c1 = thr | blo, c2 = thr | bhi, c3 = c2 | blo;
            const int n1 = RANK_CNT(c1), n2 = RANK_CNT(c2), n3 = RANK_CNT(c3);
            if (lane == 0) { if (n1) __hip_atomic_fetch_add(&sh[3 * st], (unsigned)n1, __ATOMIC_RELAXED, __HIP_MEMORY_SCOPE_WORKGROUP); if (n2) __hip_atomic_fetch_add(&sh[3 * st + 1], (unsigned)n2, __ATOMIC_RELAXED, __HIP_MEMORY_SCOPE_WORKGROUP);
                             if (n3) __hip_atomic_fetch_add(&sh[3 * st + 2], (unsigned)n3, __ATOMIC_RELAXED, __HIP_MEMORY_SCOPE_WORKGROUP); }
            __syncthreads();
            const int t1 = (int)sh[3 * st], t2 = (int)sh[3 * st + 1], t3 = (int)sh[3 * st + 2];
            thr = t2 >= cap ? (t3 >= cap ? c3 : c2) : (t1 >= cap ? c1 : thr); }
#undef RANK_CNT
        { const int c = __builtin_popcountll(__ballot(key[0] > thr)) + __builtin_popcountll(__ballot(key[1] > thr)) + __builtin_popcountll(__ballot(key[2] > thr)) + __builtin_popcountll(__ballot(key[3] > thr)); if (lane == 0 && c) __hip_atomic_fetch_add(&sh[63], (unsigned)c, __ATOMIC_RELAXED, __HIP_MEMORY_SCOPE_WORKGROUP); }
        __syncthreads();
        const int need_eq = cap - (int)sh[63];
        int feq[4], sel[4], loc = 0;
#pragma unroll
        for (int k = 0; k < 4; ++k) { feq[k] = valid[k] && key[k] == thr; loc += feq[k]; }
        int pre = block_excl_scan(loc, sh + 32, lane, wave); loc = 0;
#pragma unroll
        for (int k = 0; k < 4; ++k) { sel[k] = valid[k] && (key[k] > thr || (feq[k] && pre < need_eq)); pre += feq[k]; loc += sel[k]; }
        int slot = block_excl_scan(loc, sh + 40, lane, wave);
        const int slot0 = isx ? b * CAPX : BATCH * CAPX + b * CAPC;
#pragma unroll
        for (int k = 0; k < 4; ++k) { const int t = 4 * tid + k; if (valid[k]) { p.RANK_()[(size_t)(base + t) * NE + e] = sel[k] ? slot : (1 << 30); if (sel[k]) p.IDX_()[e * ME + slot0 + slot] = base + t; slot += sel[k]; } }
        __syncthreads();
    }
}

typedef float f32x16 __attribute__((ext_vector_type(16)));
typedef float f32x2 __attribute__((ext_vector_type(2)));
typedef __bf16 bf16x2v __attribute__((ext_vector_type(2)));
using pg8::bf16x8;
__device__ __forceinline__ unsigned pk2(float a, float b) { const f32x2 v = {a, b}; return __builtin_bit_cast(unsigned, __builtin_convertvector(v, bf16x2v)); }
__device__ __forceinline__ bf16x8 pack8(const f32x16& x, int s) { u32x4 q; q[0] = pk2(x[8 * s], x[8 * s + 1]); q[1] = pk2(x[8 * s + 2], x[8 * s + 3]); q[2] = pk2(x[8 * s + 4], x[8 * s + 5]); q[3] = pk2(x[8 * s + 6], x[8 * s + 7]); return __builtin_bit_cast(bf16x8, q); }
#define MFMA32(a, b, c) __builtin_amdgcn_mfma_f32_32x32x16_bf16((a), (b), (c), 0, 0, 0)
__device__ __forceinline__ int crow(int reg, int hh) { return (reg & 3) + 8 * (reg >> 2) + 4 * hh; }
constexpr int NCHUNK = (BX + BC) / 64, NXCH = BX / 64, NPROB = NCHUNK * GH * 2;
constexpr int GFRAGS = 56;
__device__ __forceinline__ void chunk_rows(int chunk, int& base, int& sbase, int& slen) {
    if (chunk < NXCH) { const int b = chunk / (SEQ / 64), c = chunk % (SEQ / 64); sbase = b * SEQ; slen = SEQ; base = sbase + c * 64; }
    else { const int q = chunk - NXCH, b = q / (CTX / 64), c = q % (CTX / 64); sbase = BX + b * CTX; slen = CTX; base = sbase + c * 64; }
}
constexpr int KST = 136;
constexpr int QST = 68;
constexpr int OFF_KB = 0, OFF_QB = 64 * KST * 2, OFF_VF = 2 * 64 * KST * 2, OFF_KK = OFF_VF + 64 * 128 * 4, OFF_QK = OFF_KK + 64 * 64 * 4, OFF_AT = OFF_QK + 64 * QST * 4, OFF_GC = LDS_BAR_OFF - 2048  ,
              OFF_WS = OFF_VF  ;
constexpr int IST = 72;
constexpr int OFF_TB = OFF_AT + 2 * 64 * 64 * 4  ;
static_assert(OFF_GC + 2048 <= LDS_BAR_OFF && OFF_TB + 2 * 64 * IST * 2 <= OFF_GC && OFF_WS + 2 * 64 * KST * 2 <= OFF_QK, "gdn_local LDS map");

template <int J, int IB> __device__ __forceinline__ void gdn_solve32_load(f32x4& q, const LAS float* ab) {
    constexpr int first = J + 1 - 4 * IB; const LAS float* src = ab + J * 64 + 4 * IB;
    if constexpr (first <= 0) q = *(const LAS f32x4*)src;
    else { if constexpr (first == 1) q[1] = src[1];
           if constexpr (first <= 2) { const f32x2 t = *(const LAS f32x2*)(src + 2); q[2] = t[0]; q[3] = t[1]; }
           else q[3] = src[3]; }
}
template <int J, int IB> __device__ __forceinline__ void gdn_solve32_block(float (&R)[32], const LAS float*& ab, f32x4 (&q)[8], float xj) {
    if constexpr (4 * IB + 3 > J) {
#pragma unroll
        for (int e = 0; e < 4; ++e) if (4 * IB + e > J) R[4 * IB + e] -= q[IB][e] * xj;
        if constexpr (J + 1 < 31 && 4 * IB + 3 > J + 1) {
            asm volatile("" : "+v"(R[4 * IB]), "+v"(R[4 * IB + 1]), "+v"(R[4 * IB + 2]), "+v"(R[4 * IB + 3]), "+v"(ab));
            gdn_solve32_load<J + 1, IB>(q[IB], ab); } }
}
template <int J> __device__ __forceinline__ void gdn_solve32_step(float (&R)[32], const LAS float*& ab, f32x4 (&q)[8]) {
    const float xj = R[J];
    gdn_solve32_block<J, 0>(R, ab, q, xj); gdn_solve32_block<J, 1>(R, ab, q, xj); gdn_solve32_block<J, 2>(R, ab, q, xj); gdn_solve32_block<J, 3>(R, ab, q, xj);
    gdn_solve32_block<J, 4>(R, ab, q, xj); gdn_solve32_block<J, 5>(R, ab, q, xj); gdn_solve32_block<J, 6>(R, ab, q, xj); gdn_solve32_block<J, 7>(R, ab, q, xj);
}
template <int... Js> __device__ __forceinline__ void gdn_solve32_all(float (&R)[32], const LAS float* ab, std::integer_sequence<int, Js...>) {
    f32x4 q[8];
    gdn_solve32_load<0, 0>(q[0], ab); gdn_solve32_load<0, 1>(q[1], ab); gdn_solve32_load<0, 2>(q[2], ab); gdn_solve32_load<0, 3>(q[3], ab);
    gdn_solve32_load<0, 4>(q[4], ab); gdn_solve32_load<0, 5>(q[5], ab); gdn_solve32_load<0, 6>(q[6], ab); gdn_solve32_load<0, 7>(q[7], ab);
    (gdn_solve32_step<Js>(R, ab, q), ...);
}
__device__ __forceinline__ void phase_gdn_local(const Ptrs& p, int l, LAS unsigned char* lds, int G, int wg) {
    const int tid0 = opq((int)threadIdx.x);
    LAS bf16_t* Kb = (LAS bf16_t*)(lds + OFF_KB); LAS bf16_t* Qb = (LAS bf16_t*)(lds + OFF_QB); LAS float* VF = (LAS float*)(lds + OFF_VF); LAS float* KK = (LAS float*)(lds + OFF_KK);
    LAS float* QK = (LAS float*)(lds + OFF_QK); LAS float* AT = (LAS float*)(lds + OFF_AT); LAS float* GC = (LAS float*)(lds + OFF_GC); LAS float* BL = GC + 128; LAS float* GE = GC + 384  ; LAS bf16_t* Tb = (LAS bf16_t*)(lds + OFF_TB); LAS bf16_t* Ws = (LAS bf16_t*)(lds + OFF_WS);
#pragma unroll 1
    for (int u = wg; u < NCHUNK * GH; u += G) {
        const int tid = opq(tid0), lane = tid & 63, wave = tid >> 6;
        const int chunk = u / GH, h = u % GH; int base, sbase, slen; chunk_rows(chunk, base, sbase, slen);
        const int tidu = opq(tid), gd = tidu >> 6, gtk = (gd & 1) ? 63 - (tidu & 63) : (tidu & 63); bf16_t ga_raw = 0, gb_raw = 0; float galog = 0.f, gdtb = 0.f;
        if (tidu < 128) { const size_t r = (size_t)(base + gtk); ga_raw = p.Pb_()[r * LDP + C_A + gd * GH + h]; gb_raw = p.Pb_()[r * LDP + C_B + gd * GH + h]; galog = p.gdn_a_log[(l * 2 + gd) * GH + h]; gdtb = p.gdn_dt_bias[(l * 2 + gd) * GH + h]; }
        {
            float cw[4][6];
#pragma unroll
            for (int j = 0; j < 4; ++j)
#pragma unroll
                for (int q = 0; q < 3; ++q) { const f32x2 w2 = *(const f32x2*)(p.gdn_conv_w + ((size_t)l * 4 + j) * 3 * BW + q * BW + h * GDK + 2 * lane); cw[j][2 * q] = w2[0]; cw[j][2 * q + 1] = w2[1]; }
            float rows[11][6]; unsigned raw[11][3];
#pragma unroll
            for (int rr = 0; rr < 11; ++rr) { const int r = base + wave * 8 + rr - 2; const int rc = min(max(r, sbase), sbase + slen - 1);
#pragma unroll
                for (int q = 0; q < 3; ++q) raw[rr][q] = *(const unsigned*)(p.Pb_() + (size_t)rc * LDP + q * BW + h * GDK + 2 * lane); }
            __builtin_amdgcn_sched_barrier(0);
#pragma unroll
            for (int rr = 0; rr < 11; ++rr) { const int r = base + wave * 8 + rr - 2; const bool ok = r >= sbase && r < sbase + slen;
#pragma unroll
                for (int q = 0; q < 3; ++q) { const unsigned w2 = ok ? raw[rr][q] : 0u; rows[rr][2 * q] = __uint_as_float(w2 << 16); rows[rr][2 * q + 1] = __uint_as_float(w2 & 0xffff0000u); } }
            float qk[8][4], ssq[16], S[16];
#pragma unroll
            for (int tt = 0; tt < 8; ++tt) { float v[6];
#pragma unroll
                for (int c = 0; c < 6; ++c) v[c] = siluf_(cw[0][c] * rows[tt][c] + cw[1][c] * rows[tt + 1][c] + cw[2][c] * rows[tt + 2][c] + cw[3][c] * rows[tt + 3][c]);
                qk[tt][0] = v[0]; qk[tt][1] = v[1]; qk[tt][2] = v[2]; qk[tt][3] = v[3]; ssq[2 * tt] = v[0] * v[0] + v[1] * v[1]; ssq[2 * tt + 1] = v[2] * v[2] + v[3] * v[3];
                *(LAS f32x2*)(VF + (wave * 8 + tt) * 128 + 2 * lane) = (f32x2){v[4], v[5]}; }
            wave_sum16(ssq, S, lane);
#pragma unroll
            for (int tt = 0; tt < 8; ++tt) { const float qs = __builtin_amdgcn_rsqf(S[2 * tt] + EPS) * 0.08838834764831845f, ks = __builtin_amdgcn_rsqf(S[2 * tt + 1] + EPS); const int t = wave * 8 + tt;
                *(LAS unsigned*)(Qb + t * KST + 2 * lane) = pk2(qk[tt][0] * qs, qk[tt][1] * qs); *(LAS unsigned*)(Kb + t * KST + 2 * lane) = pk2(qk[tt][2] * ks, qk[tt][3] * ks); }
        }
        unsigned touch = 0;
        { const int un = u + G; if (un < NCHUNK * GH && tid < 67 * 6) { int bn, sbn, sln; chunk_rows(un / GH, bn, sbn, sln); const int rr = tid / 6, pc = tid % 6, rc = min(max(bn - 2 + rr, sbn), sbn + sln - 1);
            touch = *(const unsigned*)(p.Pb_() + (size_t)rc * LDP + (pc >> 1) * BW + (un % GH) * GDK + (pc & 1) * 64); } }
        if (tid < 128) { const int d = gd; const float a = bf2f(ga_raw), bb = bf2f(gb_raw);
            float gcv = -expf(galog) * softplusf_(a + gdtb);
            const int lu = tidu & 63;
#pragma unroll
            for (int o = 1; o < 64; o <<= 1) { const float t2 = shup(gcv, o, lu); if (lu >= o) gcv += t2; }
            const float glast = __int_as_float(__builtin_amdgcn_readlane(__float_as_int(gcv), 63));
            GC[d * 64 + lu] = gcv; GE[d * 64 + lu] = fexp(gcv); BL[d * 64 + lu] = sigmoidf_(bb); GC[256 + d * 64 + lu] = fexp(glast - gcv); }
        __syncthreads();
        { const int which = wave >> 2, tm = (wave >> 1) & 1, tn = wave & 1, m = lane & 31, hh = lane >> 5; const LAS bf16_t* Xb = which ? Qb : Kb;
            f32x16 acc;
            { const float z = zero_f();
#pragma unroll
            for (int v = 0; v < 16; ++v) acc[v] = z; }
            { bf16x8 xa[8], xb[8];
#pragma unroll
              for (int ks = 0; ks < 8; ++ks) { xa[ks] = *(const LAS bf16x8*)(Xb + (32 * tm + m) * KST + 16 * ks + 8 * hh); xb[ks] = *(const LAS bf16x8*)(Kb + (32 * tn + m) * KST + 16 * ks + 8 * hh); }
              __builtin_amdgcn_sched_barrier(0);
#pragma unroll
              for (int ks = 0; ks < 8; ++ks) acc = MFMA32(xa[ks], xb[ks], acc); }
            LAS float* O = which ? QK : KK; const int ost = which ? QST : 64;
#pragma unroll
            for (int v = 0; v < 16; ++v) O[(32 * tm + crow(v, hh)) * ost + 32 * tn + m] = acc[v]; }
        __syncthreads();
#pragma unroll
        for (int d = 0; d < 2; ++d) { const int dm = d ? 63 : 0, ti = lane ^ dm; const float bl = BL[d * 64 + lane], gi = GC[d * 64 + lane]; float kk[8], gj[8];
#pragma unroll
            for (int m = 0; m < 8; ++m) { const int j = wave + 8 * m; kk[m] = KK[(j ^ dm) * 64 + ti]; gj[m] = GC[d * 64 + j]; }
            __builtin_amdgcn_sched_barrier(0);
#pragma unroll
            for (int m = 0; m < 8; ++m) { const int j = wave + 8 * m; AT[d * 4096 + j * 64 + lane] = lane > j ? bl * kk[m] * fexp(gi - gj[m]) : 0.f; } }
        __syncthreads();
        const int tqq = opq(tid), lqq = tqq & 63, hhq = lqq >> 5, nq = lqq & 31, wvq = __builtin_amdgcn_readfirstlane(tqq >> 6);
        bf16x8 bfr[3][4];
        if (wvq < 2) { float R[32]; const int lq = lqq, hf = lq >> 5, c = lq & 31;
#pragma unroll
            for (int i = 0; i < 32; ++i) R[i] = i == c ? 1.0f : 0.0f;
            gdn_solve32_all(R, AT + wvq * 4096 + hf * (32 * 64 + 32), std::make_integer_sequence<int, 31>{});
            LAS bf16_t* tb = Tb + wvq * 64 * IST;
#pragma unroll
            for (int i = 0; i < 32; ++i) tb[(32 * hf + i) * IST + lq] = f2bf(R[i]);
            bf16x8 af[2], bfm[2];
#pragma unroll
            for (int ks = 0; ks < 2; ++ks) { float av[8], bv[8];
#pragma unroll
                for (int jj = 0; jj < 8; ++jj) { av[jj] = AT[wvq * 4096 + (16 * ks + 8 * hf + jj) * 64 + 32 + c]; const float sw = shx(R[16 * ks + 8 + jj], 32, lq); bv[jj] = hf ? sw : R[16 * ks + jj]; }
                af[ks] = __builtin_bit_cast(bf16x8, (u32x4){pk2(av[0], av[1]), pk2(av[2], av[3]), pk2(av[4], av[5]), pk2(av[6], av[7])});
                bfm[ks] = __builtin_bit_cast(bf16x8, (u32x4){pk2(bv[0], bv[1]), pk2(bv[2], bv[3]), pk2(bv[4], bv[5]), pk2(bv[6], bv[7])}); }
            f32x16 Mx, T2; { const float z = zero_f();
#pragma unroll
            for (int v = 0; v < 16; ++v) { Mx[v] = z; T2[v] = z; } }
            Mx = MFMA32(af[0], bfm[0], Mx); Mx = MFMA32(af[1], bfm[1], Mx);
#pragma unroll
            for (int ks = 0; ks < 2; ++ks) { const LAS bf16_t* src = tb + (32 + c) * IST + 32 + 16 * ks + 4 * hf;
                const u32x2 lo = *(const LAS u32x2*)src, hi = *(const LAS u32x2*)(src + 8);
                T2 = MFMA32(__builtin_bit_cast(bf16x8, (u32x4){lo.x, lo.y, hi.x, hi.y}), pack8(Mx, ks), T2); }
#pragma unroll
            for (int v = 0; v < 16; ++v) tb[(32 + crow(v, hf)) * IST + c] = f2bf(-T2[v]); }
        else {
#pragma unroll
            for (int q = 0; q < 3; ++q) { const int T = wvq - 2 + 6 * q; if (T < 16) { const int dt = T >> 3, nt = T & 7, dmt = dt ? 63 : 0, col = 32 * nt + nq;
                if (nt >= 4) {
#pragma unroll
                    for (int ks = 0; ks < 4; ++ks) { float kv[8], sc[8];
#pragma unroll
                        for (int jj = 0; jj < 8; ++jj) { const int j = 16 * ks + 8 * hhq + jj; kv[jj] = bf2f(Kb[(j ^ dmt) * KST + col - 128]); sc[jj] = GE[dt * 64 + j] * BL[dt * 64 + j]; }
                        bfr[q][ks] = __builtin_bit_cast(bf16x8, (u32x4){pk2(kv[0] * sc[0], kv[1] * sc[1]), pk2(kv[2] * sc[2], kv[3] * sc[3]), pk2(kv[4] * sc[4], kv[5] * sc[5]), pk2(kv[6] * sc[6], kv[7] * sc[7])}); } }
                else {
#pragma unroll
                    for (int ks = 0; ks < 4; ++ks) { float vv[8], sc[8];
#pragma unroll
                        for (int jj = 0; jj < 8; ++jj) { const int j = 16 * ks + 8 * hhq + jj; vv[jj] = VF[(j ^ dmt) * 128 + col]; sc[jj] = BL[dt * 64 + j]; }
                        bfr[q][ks] = __builtin_bit_cast(bf16x8, (u32x4){pk2(vv[0] * sc[0], vv[1] * sc[1]), pk2(vv[2] * sc[2], vv[3] * sc[3]), pk2(vv[4] * sc[4], vv[5] * sc[5]), pk2(vv[6] * sc[6], vv[7] * sc[7])}); } } } }

            const LAS float* E2 = GC + 256;
#pragma unroll 1
            for (int ft = wvq - 2; ft < 64; ft += 6) { const int d2 = (ft >> 4) & 1, fl = ft & 15, dm2 = d2 ? 63 : 0; u32x4 o4; int f;
                if (ft < 32) { f = 16 + fl; const int i = 32 * (fl >> 3) + nq; const LAS bf16_t* src = Qb + (i ^ dm2) * KST + 16 * (fl & 7) + 4 * hhq; const float sc = GE[d2 * 64 + i];
                    const u32x2 lo = *(const LAS u32x2*)src, hi = *(const LAS u32x2*)(src + 8);
                    o4 = (u32x4){pk2(__uint_as_float(lo.x << 16) * sc, __uint_as_float(lo.x & 0xffff0000u) * sc), pk2(__uint_as_float(lo.y << 16) * sc, __uint_as_float(lo.y & 0xffff0000u) * sc),
                                 pk2(__uint_as_float(hi.x << 16) * sc, __uint_as_float(hi.x & 0xffff0000u) * sc), pk2(__uint_as_float(hi.y << 16) * sc, __uint_as_float(hi.y & 0xffff0000u) * sc)}; }
                else { f = 40 + fl; const int dk = 32 * (fl >> 2) + nq, c0 = 16 * (fl & 3) + 4 * hhq; const f32x4 ea = *(const LAS f32x4*)(E2 + d2 * 64 + c0), eb = *(const LAS f32x4*)(E2 + d2 * 64 + c0 + 8); float kv[8];
#pragma unroll
                    for (int e = 0; e < 4; ++e) { kv[e] = bf2f(Kb[((c0 + e) ^ dm2) * KST + dk]) * ea[e]; kv[4 + e] = bf2f(Kb[((c0 + 8 + e) ^ dm2) * KST + dk]) * eb[e]; }
                    o4 = (u32x4){pk2(kv[0], kv[1]), pk2(kv[2], kv[3]), pk2(kv[4], kv[5]), pk2(kv[6], kv[7])}; }
                *(u32x4*)(p.GFR_() + ((size_t)((chunk * GH + h) * 2 + d2) * GFRAGS + f) * 512 + lqq * 8) = o4; }
        }
        __syncthreads();
        if (wvq >= 2) {
#pragma unroll
          for (int q = 0; q < 3; ++q) { const int T = wvq - 2 + 6 * q; if (T < 16) { const int dt = T >> 3, nt = T & 7; f32x16 acc[2]; bf16x8 tf[2][4];
#pragma unroll
              for (int tm = 0; tm < 2; ++tm)
#pragma unroll
                  for (int ks = 0; ks < (tm ? 4 : 2); ++ks) tf[tm][ks] = *(const LAS bf16x8*)(Tb + (dt * 64 + 32 * tm + nq) * IST + 16 * ks + 8 * hhq);
#pragma unroll
              for (int tm = 0; tm < 2; ++tm) { const float z = zero_f();
#pragma unroll
                  for (int e = 0; e < 16; ++e) acc[tm][e] = z; }
#pragma unroll
              for (int ks = 0; ks < 4; ++ks)
#pragma unroll
                  for (int tm = (ks < 2 ? 0 : 1); tm < 2; ++tm) acc[tm] = MFMA32(tf[tm][ks], bfr[q][ks], acc[tm]);
              if (nt < 4) { float* up = p.GU_() + (size_t)((chunk * GH + h) * 2 + dt) * 8192 + nt * 2048 + lane * 4;
#pragma unroll
                  for (int tm = 0; tm < 2; ++tm)
#pragma unroll
                      for (int iq = 0; iq < 4; ++iq) *(f32x4*)(up + (tm * 4 + iq) * 256) = (f32x4){acc[tm][4 * iq], acc[tm][4 * iq + 1], acc[tm][4 * iq + 2], acc[tm][4 * iq + 3]}; }
              else { LAS bf16_t* wp = Ws + (dt * 64 + 4 * hhq) * KST + 32 * (nt - 4) + nq;
#pragma unroll
                  for (int tm = 0; tm < 2; ++tm)
#pragma unroll
                      for (int e = 0; e < 16; ++e) wp[(32 * tm + crow(e, 0)) * KST] = f2bf(acc[tm][e]); } } } }
        __syncthreads();
        { u32x2 wlo[4], whi[4];
#pragma unroll
          for (int q = 0; q < 4; ++q) { const int ft = wvq + 8 * q, d2 = ft >> 4, f = ft & 15; const LAS bf16_t* src = Ws + (d2 * 64 + 32 * (f >> 3) + nq) * KST + 16 * (f & 7) + 4 * hhq; wlo[q] = *(const LAS u32x2*)src; whi[q] = *(const LAS u32x2*)(src + 8); }
          __builtin_amdgcn_sched_barrier(0);
#pragma unroll
          for (int q = 0; q < 4; ++q) { const int ft = wvq + 8 * q, d2 = ft >> 4, f = ft & 15;
              *(u32x4*)(p.GFR_() + ((size_t)((chunk * GH + h) * 2 + d2) * GFRAGS + f) * 512 + lqq * 8) = (u32x4){wlo[q].x, wlo[q].y, whi[q].x, whi[q].y}; } }
#pragma unroll
        for (int q2 = 0; q2 < 2; ++q2) { const int ft = 32 + wvq + 8 * q2; u32x4 o4; int f, d2;
            { d2 = (ft >> 3) & 1; const int fl = ft & 7; f = 32 + fl; const int ci = 32 * (fl >> 2) + nq, c0 = 16 * (fl & 3) + 4 * hhq; const LAS float* gc = GC + d2 * 64;
                const float gci = gc[ci]; const f32x4 ga = *(const LAS f32x4*)(gc + c0), gb = *(const LAS f32x4*)(gc + c0 + 8);
                const LAS float* qs = QK + (d2 ? (63 - ci) * QST + 60 - c0 : ci * QST + c0); const f32x4 ra = *(const LAS f32x4*)qs, rb = *(const LAS f32x4*)(qs + (d2 ? -8 : 8)); float kv[8];
#pragma unroll
                for (int e = 0; e < 4; ++e) { const float xa = d2 ? ra[3 - e] : ra[e], xb = d2 ? rb[3 - e] : rb[e];
                    kv[e] = c0 + e <= ci ? xa * fexp(gci - ga[e]) : 0.f; kv[4 + e] = c0 + 8 + e <= ci ? xb * fexp(gci - gb[e]) : 0.f; }
                o4 = (u32x4){pk2(kv[0], kv[1]), pk2(kv[2], kv[3]), pk2(kv[4], kv[5]), pk2(kv[6], kv[7])}; }
            *(u32x4*)(p.GFR_() + ((size_t)((chunk * GH + h) * 2 + d2) * GFRAGS + f) * 512 + lqq * 8) = o4; }
        if (tid == 0 || tid == 256) p.GEG_()[(chunk * GH + h) * 2 + (tid >> 8)] = GE[(tid >> 8) * 64 + 63];
        asm volatile("" :: "v"(touch));
        __syncthreads();
    }
}
constexpr int SCAN_WGS = BATCH * GH * 2 * 2;
constexpr int SCAN_BUF = (GFRAGS + 16) * 1024;
static_assert(2 * SCAN_BUF <= LDS_BAR_OFF && SCAN_WGS <= NWG / 2, "scan LDS / workgroup split");
__device__ __forceinline__ void phase_gdn_scan(const Ptrs& p, LAS unsigned char* lds, int wg) {
    const int tid = opq((int)threadIdx.x), lane = tid & 63, wave = __builtin_amdgcn_readfirstlane(tid >> 6), hh = lane >> 5;
    constexpr int NSTEP = (CTX + SEQ) / 64;
    {
        const int task = (wg % 8) * (SCAN_WGS / 8) + wg / 8, pair = task & 1, d = (task >> 1) & 1, h = (task >> 2) % GH, b = task / (4 * GH);
        const int sl = 2 * pair + (wave & 1);
        f32x16 S[4];
#pragma unroll
        for (int kb = 0; kb < 4; ++kb)
            { const float z = zero_f();
#pragma unroll
            for (int v = 0; v < 16; ++v) S[kb][v] = z; }
#define GDN_CHUNK(k) ((k) < CTX / 64 ? NXCH + b * (CTX / 64) + (d ? CTX / 64 - 1 - (k) : (k)) : b * (SEQ / 64) + (d ? SEQ / 64 - 1 - ((k) - CTX / 64) : (k) - CTX / 64))
#define GDN_LOAD(k, buf) do { const int _pr = (GDN_CHUNK(k) * GH + h) * 2 + d; _Pragma("unroll") for (int _i = 0; _i < 9; ++_i) { const int _f = wave * 9 + _i; \
            const char* _src = _f < GFRAGS ? (const char*)(p.GFR_() + ((size_t)_pr * GFRAGS + _f) * 512) : (const char*)(p.GU_() + (size_t)_pr * 8192 + (2 * pair + (_f - GFRAGS) / 8) * 2048 + ((_f - GFRAGS) % 8) * 256); \
            __builtin_amdgcn_global_load_lds((const unsigned*)(_src + lane * 16), (LAS unsigned*)(lds + (buf) * SCAN_BUF + _f * 1024), 16, 0, 0); } } while (0)
        GDN_LOAD(0, 0);
        float egn = p.GEG_()[(GDN_CHUNK(0) * GH + h) * 2 + d];
#pragma unroll 1
        for (int k = 0; k < NSTEP; ++k) {
            asm volatile("s_waitcnt vmcnt(0)" ::: "memory"); __syncthreads();
            const float eg = egn; if (k + 1 < NSTEP) egn = p.GEG_()[(GDN_CHUNK(k + 1) * GH + h) * 2 + d];
            if (k + 1 < NSTEP) GDN_LOAD(k + 1, (k + 1) & 1);
            if (wave < 2) {
                const LAS unsigned char* fb = lds + (k & 1) * SCAN_BUF + lane * 16; const int chunk = GDN_CHUNK(k), prob = (chunk * GH + h) * 2 + d;
                const LAS unsigned char* ub = fb + (GFRAGS + wave * 8) * 1024;
#define FR(f) (*(const LAS bf16x8*)(fb + (f) * 1024))
                f32x16 ws[2], o[2];
#pragma unroll
                for (int cm = 0; cm < 2; ++cm)
                    { const float z = zero_f();
#pragma unroll
                    for (int v = 0; v < 16; ++v) { ws[cm][v] = z; o[cm][v] = z; } }
                bf16x8 fa[8], fc[8];
#define LDG1(dst, g) do { _Pragma("unroll") for (int _q = 0; _q < 2; ++_q) _Pragma("unroll") for (int _cm = 0; _cm < 2; ++_cm) { \
                    dst[_q * 4 + _cm * 2] = FR(_cm * 8 + 2 * (g) + _q); dst[_q * 4 + _cm * 2 + 1] = FR(16 + _cm * 8 + 2 * (g) + _q); } } while (0)
#define MMG1(src, g) do { _Pragma("unroll") for (int _q = 0; _q < 2; ++_q) { const int _ks = 2 * (g) + _q; const bf16x8 sbk = pack8(S[_ks >> 1], _ks & 1); \
                    _Pragma("unroll") for (int _cm = 0; _cm < 2; ++_cm) { ws[_cm] = MFMA32(src[_q * 4 + _cm * 2], sbk, ws[_cm]); o[_cm] = MFMA32(src[_q * 4 + _cm * 2 + 1], sbk, o[_cm]); } } } while (0)
                LDG1(fa, 0); __builtin_amdgcn_sched_barrier(0);
                LDG1(fc, 1); __builtin_amdgcn_sched_barrier(0); MMG1(fa, 0); __builtin_amdgcn_sched_barrier(0);
                LDG1(fa, 2); __builtin_amdgcn_sched_barrier(0); MMG1(fc, 1); __builtin_amdgcn_sched_barrier(0);
                LDG1(fc, 3); __builtin_amdgcn_sched_barrier(0); MMG1(fa, 2); __builtin_amdgcn_sched_barrier(0);
                f32x4 uu[8];
#pragma unroll
                for (int q = 0; q < 8; ++q) uu[q] = *(const LAS f32x4*)(ub + q * 1024);
                __builtin_amdgcn_sched_barrier(0); MMG1(fc, 3); __builtin_amdgcn_sched_barrier(0);
#undef LDG1
#undef MMG1
#pragma unroll
                for (int q = 0; q < 8; ++q) if (q != 2 && q != 3) fa[q] = FR(32 + q);
                __builtin_amdgcn_sched_barrier(0);
                bf16x8 vb[4];
#pragma unroll
                for (int cm = 0; cm < 2; ++cm) { f32x16 vn;
#pragma unroll
                    for (int iq = 0; iq < 4; ++iq)
#pragma unroll
                        for (int e = 0; e < 4; ++e) vn[4 * iq + e] = uu[cm * 4 + iq][e] - ws[cm][4 * iq + e];
                    vb[2 * cm] = pack8(vn, 0); vb[2 * cm + 1] = pack8(vn, 1); }
                __builtin_amdgcn_sched_barrier(0);
#pragma unroll
                for (int q = 0; q < 8; ++q) fc[q] = FR(40 + q);
                __builtin_amdgcn_sched_barrier(0);
#pragma unroll
                for (int cm = 0; cm < 2; ++cm)
#pragma unroll
                    for (int ks = 0; ks < (cm ? 4 : 2); ++ks) o[cm] = MFMA32(fa[cm * 4 + ks], vb[ks], o[cm]);
                __builtin_amdgcn_sched_barrier(0);
#pragma unroll
                for (int q = 0; q < 8; ++q) fa[q] = FR(48 + q);
                __builtin_amdgcn_sched_barrier(0);
#pragma unroll
                for (int kb = 0; kb < 2; ++kb) { S[kb] = S[kb] * eg;
#pragma unroll
                    for (int ks = 0; ks < 4; ++ks) S[kb] = MFMA32(fc[kb * 4 + ks], vb[ks], S[kb]); }
                __builtin_amdgcn_sched_barrier(0);
#pragma unroll
                for (int kb = 2; kb < 4; ++kb) { S[kb] = S[kb] * eg;
#pragma unroll
                    for (int ks = 0; ks < 4; ++ks) S[kb] = MFMA32(fa[(kb - 2) * 4 + ks], vb[ks], S[kb]); }
                int base, sbase, slen; chunk_rows(chunk, base, sbase, slen);
                const int sgn = d ? -BW : BW;
                bf16_t* op = (bf16_t*)p.GO_() + ((size_t)d * NR + base + (d ? 63 : 0)) * BW + h * GDK + sl * 32 + (lane & 31) + 4 * opq(hh) * sgn;
#pragma unroll
                for (int cm = 0; cm < 2; ++cm)
#pragma unroll
                    for (int v = 0; v < 16; v += 2) { const unsigned w = pk2(o[cm][v], o[cm][v + 1]); op[(32 * cm + crow(v, 0)) * sgn] = (bf16_t)w; op[(32 * cm + crow(v + 1, 0)) * sgn] = (bf16_t)(w >> 16); }
#undef FR
            }
        }
        __syncthreads();
#undef GDN_LOAD
#undef GDN_CHUNK
    }
}
constexpr float SWA_QSCALE = 0.125f * 1.4426950408889634f;
__device__ __forceinline__ void phase_swa_prep(const Ptrs& p, int l, int G, int wg) {
    const int tid = opq((int)threadIdx.x), lane = tid & 63, wave = tid >> 6, i = lane & 31, hsel = lane >> 5;
    const int m = i & 15; const float inv = exp2f(-(float)m * (13.287712379549449f / 16.0f));
    const f32x2 gq = *(const f32x2*)(p.swa_qnorm_g + l * HD + 2 * i), gk = *(const f32x2*)(p.swa_knorm_g + l * HD + 2 * i);
    unsigned wq[(QH + KVH) / 2], wn[(QH + KVH) / 2];
    constexpr int PA = 57, PC = 18, PB = 110; static_assert(128 * PA + 32 * PC + 96 * PB == NR, "prep row split");
    const int rbeg = wg < 128 ? wg * PA : wg < 160 ? 128 * PA + (wg - 128) * PC : 128 * PA + 32 * PC + (wg - 160) * PB, rend = rbeg + (wg < 128 ? PA : wg < 160 ? PC : PB);
    const int r0 = rbeg + wave;
    if (r0 < rend) {
#pragma unroll
        for (int it = 0; it < (QH + KVH) / 2; ++it) { const int hh = 2 * it + hsel; wq[it] = *(const unsigned*)(p.Pb_() + (size_t)r0 * LDP + (hh < QH ? C_SQ + hh * HD : C_SK + (hh - QH) * HD) + 2 * i); } }
#pragma unroll 1
    for (int r = r0; r < rend; r += 8) {
        const int rn = r + 8 < rend ? r + 8 : r;
#pragma unroll
        for (int it = 0; it < (QH + KVH) / 2; ++it) { const int hh = 2 * it + hsel; wn[it] = *(const unsigned*)(p.Pb_() + (size_t)rn * LDP + (hh < QH ? C_SQ + hh * HD : C_SK + (hh - QH) * HD) + 2 * i); }
        const bool isx = r < BX; const int t = isx ? r % SEQ : 0; const float pos = i < 16 ? (float)(t / GRID_W) : (float)(t % GRID_W);
        float sn = 0.f, cs = 1.f; if (isx) { const float rev = pos * inv * 0.15915494309189535f; sn = __builtin_amdgcn_sinf(rev); cs = __builtin_amdgcn_cosf(rev); }
#pragma unroll
        for (int it = 0; it < (QH + KVH) / 2; ++it) { const int hh = 2 * it + hsel; const bool isq = hh < QH;
            const unsigned w2 = wq[it];
            const float a = __uint_as_float(w2 << 16), bb = __uint_as_float(w2 & 0xffff0000u);
            float ss = a * a + bb * bb; ss += shx(ss, 16, lane); ss += shx(ss, 8, lane); ss += shx(ss, 4, lane); ss += shx(ss, 2, lane); ss += shx(ss, 1, lane);
            const float rs = __builtin_amdgcn_rsqf(ss * (1.0f / HD) + EPS) * (isq ? SWA_QSCALE : 1.0f); const f32x2 gn = isq ? gq : gk;
            const float t1 = a * rs * gn[0], t2 = bb * rs * gn[1];
            const unsigned o = pk2(t1 * cs - t2 * sn, t1 * sn + t2 * cs);
            if (isq) *(unsigned*)(p.SQb_() + (size_t)r * QH * HD + hh * HD + 2 * i) = o; else *(unsigned*)(p.SKb_() + (size_t)r * KVH * HD + (hh - QH) * HD + 2 * i) = o; }
#pragma unroll
        for (int it = 0; it < (QH + KVH) / 2; ++it) wq[it] = wn[it];
    }
}
constexpr int SST = 72, SSTV = 68  , SWA_XUNITS = BATCH * KVH * (SEQ / 64), SWA_UNITS = SWA_XUNITS + BATCH * KVH * (CTX / 64);
__device__ __forceinline__ void phase_swa_attn(const Ptrs& p, int l, LAS unsigned char* lds, int G, int wg, bool xonly) {
    const int tid = opq((int)threadIdx.x), lane = tid & 63, wave = tid >> 6, n = lane & 31, hh = lane >> 5, g = wave >> 1, th = wave & 1;
    const int lkey = tid >> 3, lc8 = (tid & 7) * 8;
    u32x4 kreg = {0u, 0u, 0u, 0u}, vreg = kreg, kr1 = kreg, vr1 = kreg, kr2 = kreg, vr2 = kreg;
    bool first = true;
    const int NU = xonly ? SWA_XUNITS : SWA_UNITS;
#define SWA_GEOM(u_, kvh_, bx_, cb_, jlo_, nl_) do { const bool _isx = (u_) < SWA_XUNITS; const int _v = _isx ? (u_) : (u_) - SWA_XUNITS, _nqb = _isx ? SEQ / 64 : CTX / 64, _b = _v / (KVH * _nqb), _q0 = (_v % _nqb) * 64; \
        kvh_ = (_v / _nqb) % KVH; cb_ = BX + _b * CTX; bx_ = _b * SEQ + _q0 - 128; jlo_ = _isx ? (_q0 >= 128 ? 0 : (128 - _q0) / 64) : 0; \
        const int _jhi = _isx ? ((SEQ - 1 - (_q0 - 128)) / 64 < 4 ? (SEQ - 1 - (_q0 - 128)) / 64 : 4) : -1; nl_ = _jhi - jlo_ + 1; } while (0)
#define SWA_LOADG(kd, vd, vt_, kvh_, bx_, cb_, jlo_, nl_) do { const size_t _r = (size_t)((vt_) < (nl_) ? (bx_) + 64 * ((jlo_) + (vt_)) : (cb_) + 64 * ((vt_) - (nl_))) + lkey; \
        kd = *(const u32x4*)(p.SKb_() + _r * KVH * HD + (kvh_) * HD + lc8); vd = *(const u32x4*)(p.Pb_() + _r * LDP + C_SV + (kvh_) * HD + lc8); } while (0)
#pragma unroll 1
    for (int u = wg; u < NU; u += G) {
        const bool isx = u < SWA_XUNITS; const int v = isx ? u : u - SWA_XUNITS, nqb = isx ? SEQ / 64 : CTX / 64;
        const int b = v / (KVH * nqb), kvh = (v / nqb) % KVH, qb = v % nqb, q0 = qb * 64, hq = kvh * SGRP + g;
        const int cbase = BX + b * CTX, xbase = b * SEQ;
        const int jlo = isx ? (q0 >= 128 ? 0 : (128 - q0) / 64) : 0, jhi = isx ? ((SEQ - 1 - (q0 - 128)) / 64 < 4 ? (SEQ - 1 - (q0 - 128)) / 64 : 4) : -1, nl = jhi - jlo + 1, nt = nl + CTX / 64;
        const size_t qrow = (size_t)(isx ? xbase : cbase) + q0 + 32 * th + n;
        bf16x8 qf[4];
#pragma unroll
        for (int ks = 0; ks < 4; ++ks) qf[ks] = *(const bf16x8*)(p.SQb_() + qrow * QH * HD + hq * HD + 16 * ks + 8 * hh);
        float mrun = p.swa_sink[l * QH + hq] * 1.4426950408889634f, lsum = 1.0f;
        f32x16 O[2];
#pragma unroll
        for (int dt = 0; dt < 2; ++dt)
            { const float z = zero_f();
#pragma unroll
            for (int e = 0; e < 16; ++e) O[dt][e] = z; }
#define SWA_TROW(vt) ((vt) < nl ? xbase + q0 - 128 + 64 * (jlo + (vt)) : cbase + 64 * ((vt) - nl))
#define SWA_LOADT(kd, vd, vt_) do { const size_t _r = (size_t)SWA_TROW(vt_) + lkey; kd = *(const u32x4*)(p.SKb_() + _r * KVH * HD + kvh * HD + lc8); vd = *(const u32x4*)(p.Pb_() + _r * LDP + C_SV + kvh * HD + lc8); } while (0)
        if (first) { SWA_LOADT(kreg, vreg, 0); SWA_LOADT(kr1, vr1, 1); SWA_LOADT(kr2, vr2, 2); first = false; }
        const int un = u + G; const bool has_next = un < NU; int n_kvh = 0, n_bx = 0, n_cb = 0, n_jlo = 0, n_nl = 0; if (has_next) SWA_GEOM(un, n_kvh, n_bx, n_cb, n_jlo, n_nl);
#pragma unroll 1
        for (int vt = 0; vt < nt; ++vt) {
            LAS bf16_t* KS = (LAS bf16_t*)(lds + (vt & 1) * (2 * 64 * SST * 2)); LAS bf16_t* VT = KS + 64 * SST;
            *(LAS u32x4*)(KS + lkey * SST + lc8) = kreg;
            { const unsigned w4[4] = {vreg.x, vreg.y, vreg.z, vreg.w};
#pragma unroll
              for (int e = 0; e < 4; ++e) { VT[(lc8 + 2 * e) * SSTV + lkey] = (bf16_t)(w4[e] & 0xffffu); VT[(lc8 + 2 * e + 1) * SSTV + lkey] = (bf16_t)(w4[e] >> 16); } }
            __syncthreads();
            kreg = kr1; vreg = vr1; kr1 = kr2; vr1 = vr2; if (vt + 3 < nt) SWA_LOADT(kr2, vr2, vt + 3); else if (has_next) SWA_LOADG(kr2, vr2, vt + 3 - nt, n_kvh, n_bx, n_cb, n_jlo, n_nl);
            f32x16 S[2];
            bf16x8 kf[8]; u32x2 vlo[8], vhi[8];
#pragma unroll
            for (int q = 0; q < 8; ++q) kf[q] = *(const LAS bf16x8*)(KS + (32 * (q >> 2) + n) * SST + 16 * (q & 3) + 8 * hh);
            __builtin_amdgcn_sched_barrier(0);
#pragma unroll
            for (int q = 0; q < 8; ++q) { const LAS bf16_t* vr = VT + (32 * (q & 1) + n) * SSTV + 16 * (q >> 1) + 4 * hh; vlo[q] = *(const LAS u32x2*)vr; vhi[q] = *(const LAS u32x2*)(vr + 8); }
            __builtin_amdgcn_sched_barrier(0);
#pragma unroll
            for (int km = 0; km < 2; ++km) {
                { const float z = zero_f();
#pragma unroll
                for (int e = 0; e < 16; ++e) S[km][e] = z; }
#pragma unroll
                for (int ks = 0; ks < 4; ++ks) S[km] = MFMA32(kf[km * 4 + ks], qf[ks], S[km]); }
            __builtin_amdgcn_sched_barrier(0);
            if (vt < nl) { const int j = jlo + vt;
                if (j == 0 || j == 4) { const int qt = 32 * th + n;
#pragma unroll
                    for (int km = 0; km < 2; ++km)
#pragma unroll
                        for (int e = 0; e < 16; ++e) { const int ko = -128 + 64 * j + 32 * km + crow(e, hh); const bool ok = j == 0 ? ko >= qt - 128 : ko <= qt + 128; S[km][e] = ok ? S[km][e] : -1e30f; } } }
            float mx = S[0][0];
#pragma unroll
            for (int km = 0; km < 2; ++km)
#pragma unroll
                for (int e = 0; e < 16; ++e) mx = fmaxf(mx, S[km][e]);
            mx = fmaxf(mx, shx(mx, 32, lane)); const float mnew = fmaxf(mrun, mx), alpha = __builtin_amdgcn_exp2f(mrun - mnew); mrun = mnew;
            float rsum = 0.f;
#pragma unroll
            for (int km = 0; km < 2; ++km)
#pragma unroll
                for (int e = 0; e < 16; ++e) { S[km][e] = __builtin_amdgcn_exp2f(S[km][e] - mnew); rsum += S[km][e]; }
            rsum += shx(rsum, 32, lane); lsum = lsum * alpha + rsum;
#pragma unroll
            for (int dt = 0; dt < 2; ++dt) O[dt] = O[dt] * alpha;
#pragma unroll
            for (int ks = 0; ks < 4; ++ks) { const bf16x8 pb = pack8(S[ks >> 1], ks & 1);
#pragma unroll
                for (int dt = 0; dt < 2; ++dt) O[dt] = MFMA32(__builtin_bit_cast(bf16x8, (u32x4){vlo[ks * 2 + dt].x, vlo[ks * 2 + dt].y, vhi[ks * 2 + dt].x, vhi[ks * 2 + dt].y}), pb, O[dt]); }
        }
#undef SWA_TROW
#undef SWA_LOADT
        const float il = 1.0f / lsum; bf16_t* op = p.BRb_() + qrow * 3 * BW + BW + hq * HD + 4 * hh;
#pragma unroll
        for (int dt = 0; dt < 2; ++dt)
#pragma unroll
            for (int gq = 0; gq < 4; ++gq) *(u32x2*)(op + 32 * dt + 8 * gq) = (u32x2){pk2(O[dt][4 * gq] * il, O[dt][4 * gq + 1] * il), pk2(O[dt][4 * gq + 2] * il, O[dt][4 * gq + 3] * il)};
        __syncthreads();
    }
}

constexpr int UST = 520;
template <int DIR> __device__ __forceinline__ void lru_scan_tile(f32x16 (&A)[2], f32x16 (&B)[2], int hh, int lane) {
    float h = 0.f, P = 1.f;
#pragma unroll
    for (int gi = 0; gi < 8; ++gi) { const int g2 = DIR ? 7 - gi : gi, tm = g2 >> 2, vg = g2 & 3;
        float rh[4], rP[4];
        { float ch = h, cP = P;
#pragma unroll
          for (int e = 0; e < 4; ++e) { const int v = 4 * vg + (DIR ? 3 - e : e); ch = A[tm][v] * ch + B[tm][v]; cP = A[tm][v] * cP; }
          const float th = shx(ch, 32, lane), tP = shx(cP, 32, lane);
          const bool second = DIR ? hh == 0 : hh == 1; ch = second ? th : h; cP = second ? tP : P;
#pragma unroll
          for (int e = 0; e < 4; ++e) { const int v = 4 * vg + (DIR ? 3 - e : e); ch = A[tm][v] * ch + B[tm][v]; cP = A[tm][v] * cP; rh[e] = ch; rP[e] = cP; }
          h = shx(ch, 32, lane); P = shx(cP, 32, lane); }
#pragma unroll
        for (int e = 0; e < 4; ++e) { const int v = 4 * vg + (DIR ? 3 - e : e); B[tm][v] = rh[e]; A[tm][v] = rP[e]; }
    }
}
__device__ __forceinline__ void phase_lru_local(const Ptrs& p, int l, LAS unsigned char* lds, int G, int wg) {
    const int tid = opq((int)threadIdx.x), lane = tid & 63, wave = tid >> 6, n = lane & 31, hh = lane >> 5;
    LAS bf16_t* Ub = (LAS bf16_t*)lds;
#pragma unroll 1
    for (int it = 0; it < 2; ++it) {
        const int chunk = it == 0 ? wg : (wg >= NWG / 2 && wg - NWG / 2 < NCHUNK - NWG ? NWG + wg - NWG / 2 : -1);
        if (chunk < 0 || chunk >= NCHUNK) continue;
        int base, sbase, slen; chunk_rows(chunk, base, sbase, slen);
        const int kb = wave;
        bf16x8 wbr[4], wbi[4]; float pbr, pbi, plm;
#define LRU_WLOAD(q) do { const int _d = (q) >> 1, _tn = (q) & 1, _c = kb * 64 + 32 * _tn + n; const bf16_t* _wr = p.Wt_lg_() + ((size_t)((_d * 2 + 0) * LB + kb) * LBW + 32 * _tn + n) * LBW + 8 * hh; const bf16_t* _wi = _wr + (size_t)LB * LBW * LBW; \
            _Pragma("unroll") for (int _ks = 0; _ks < 4; ++_ks) { wbr[_ks] = *(const bf16x8*)(_wr + 16 * _ks); wbi[_ks] = *(const bf16x8*)(_wi + 16 * _ks); } \
            pbr = p.lru_gate_b[((l * 2 + _d) * 2 + 0) * LW + _c]; pbi = p.lru_gate_b[((l * 2 + _d) * 2 + 1) * LW + _c]; plm = p.lru_lambda[(l * 2 + _d) * LW + _c]; } while (0)
        LRU_WLOAD(0);
        { const int cp = tid & 255, half = tid >> 8;
          float w[4][2];
#pragma unroll
          for (int j = 0; j < 4; ++j) { const f32x2 w2 = *(const f32x2*)(p.lru_conv_w + ((size_t)l * 4 + j) * LW + 2 * cp); w[j][0] = w2[0]; w[j][1] = w2[1]; }
          const f32x2 bias = *(const f32x2*)(p.lru_conv_b + l * LW + 2 * cp);
          unsigned xr[35];
#pragma unroll
          for (int j = 0; j < 35; ++j) { const int r = base + 32 * half + j - 2; xr[j] = (r >= sbase && r < sbase + slen) ? *(const unsigned*)(p.Pb_() + (size_t)r * LDP + C_LX + 2 * cp) : 0u; }
#pragma unroll
          for (int t = 0; t < 32; ++t) {
              float u0 = bias[0], u1 = bias[1];
#pragma unroll
              for (int j = 0; j < 4; ++j) { u0 += w[j][0] * __uint_as_float(xr[t + j] << 16); u1 += w[j][1] * __uint_as_float(xr[t + j] & 0xffff0000u); }
              *(LAS unsigned*)(Ub + (32 * half + t) * UST + 2 * cp) = pk2(u0, u1); } }
        __syncthreads();
#pragma unroll 1
        for (int dt2 = 0; dt2 < 4; ++dt2) { const int d = dt2 >> 1, tn = dt2 & 1;
            f32x16 A2[2], B2[2];
#pragma unroll
            for (int tm = 0; tm < 2; ++tm)
                { const float z = zero_f();
#pragma unroll
                for (int e = 0; e < 16; ++e) { A2[tm][e] = z; B2[tm][e] = z; } }
            { bf16x8 af[4][2];
#pragma unroll
              for (int ks = 0; ks < 4; ++ks)
#pragma unroll
                  for (int tm = 0; tm < 2; ++tm) af[ks][tm] = *(const LAS bf16x8*)(Ub + (32 * tm + n) * UST + kb * 64 + 16 * ks + 8 * hh);
              __builtin_amdgcn_sched_barrier(0);
#pragma unroll
              for (int ks = 0; ks < 4; ++ks)
#pragma unroll
                  for (int tm = 0; tm < 2; ++tm) { A2[tm] = MFMA32(af[ks][tm], wbr[ks], A2[tm]); B2[tm] = MFMA32(af[ks][tm], wbi[ks], B2[tm]); } }
            const int c = kb * 64 + 32 * tn + n;
            const float br_ = pbr, bi_ = pbi, sp8 = -8.0f * softplusf_(-plm);
            if (dt2 < 3) LRU_WLOAD(dt2 + 1);
            const LAS bf16_t* ub = Ub + 4 * opq(hh) * UST + c;
#pragma unroll
            for (int tm = 0; tm < 2; ++tm)
#pragma unroll
                for (int e = 0; e < 16; ++e) { const float la = sp8 * sigmoidf_(A2[tm][e] + br_), uu = bf2f(ub[(32 * tm + crow(e, 0)) * UST]);
                    const float y = 2.0f * la; A2[tm][e] = fexp(la);
                    const float om = y > -0.5f ? -y * (1.0f + y * (0.5f + y * (0.16666667f + y * (0.041666668f + y * (0.0083333338f + y * 0.0013888889f))))) : 1.0f - A2[tm][e] * A2[tm][e];
                    B2[tm][e] = __builtin_amdgcn_sqrtf(om) * (sigmoidf_(B2[tm][e] + bi_) * uu); }
            if (d == 0) lru_scan_tile<0>(A2, B2, hh, lane); else lru_scan_tile<1>(A2, B2, hh, lane);
            unsigned* ha = (unsigned*)p.LA_() + ((size_t)d * NR + base + 4 * opq(hh)) * LW + c;
#pragma unroll
            for (int tm = 0; tm < 2; ++tm)
#pragma unroll
                for (int e = 0; e < 16; ++e) { const int t = 32 * tm + crow(e, 0); ha[(size_t)t * LW] = pk2(B2[tm][e], A2[tm][e]); }
            if (hh == (d ? 0 : 1)) { p.LSA_()[((size_t)d * NCHUNK + chunk) * LW + c] = d ? A2[0][0] : A2[1][15]; p.LSH_()[((size_t)d * NCHUNK + chunk) * LW + c] = d ? B2[0][0] : B2[1][15]; }
        }
        __syncthreads();
    }
}
#undef LRU_WLOAD
__device__ __forceinline__ void lru_carry_body(const Ptrs& p, const long g) {
    if (g >= (long)BATCH * 2 * LW) return; const int c = (int)(g % LW), d = (int)(g / LW) % 2, b = (int)(g / (2 * LW)); float carry = 0.f;
    constexpr int NK = (CTX + SEQ) / 64; float sa[NK], sh[NK];
#define LRU_CHUNK_OF(k) ((k) < CTX / 64 ? NXCH + b * (CTX / 64) + (d ? CTX / 64 - 1 - (k) : (k)) : b * (SEQ / 64) + (d ? SEQ / 64 - 1 - ((k) - CTX / 64) : (k) - CTX / 64))
#pragma unroll
    for (int k = 0; k < NK; ++k) { const size_t o = ((size_t)d * NCHUNK + LRU_CHUNK_OF(k)) * LW + c; sa[k] = p.LSA_()[o]; sh[k] = p.LSH_()[o]; }
#pragma unroll
    for (int k = 0; k < NK; ++k) { const size_t o = ((size_t)d * NCHUNK + LRU_CHUNK_OF(k)) * LW + c; p.LSC_()[o] = carry; carry = sa[k] * carry + sh[k]; }
#undef LRU_CHUNK_OF
}
struct FinRow { u32x4 o0, o1; u32x4 zz, yy; u32x4 ha[2][2]; };
__device__ __forceinline__ void fin_load(FinRow& q, const Ptrs& p, int r, int lane) {
    const bf16_t* o0 = (const bf16_t*)p.GO_() + (size_t)r * BW + lane * 8;
    q.o0 = *(const u32x4*)o0; q.o1 = *(const u32x4*)(o0 + (size_t)NR * BW);
    q.zz = *(const u32x4*)(p.Pb_() + (size_t)r * LDP + C_Z + lane * 8); q.yy = *(const u32x4*)(p.Pb_() + (size_t)r * LDP + C_LY + lane * 8);
#pragma unroll
    for (int d = 0; d < 2; ++d) { const size_t o = ((size_t)d * NR + r) * LW + lane * 8;
        q.ha[d][0] = *(const u32x4*)((const unsigned*)p.LA_() + o); q.ha[d][1] = *(const u32x4*)((const unsigned*)p.LA_() + o + 4); }
}
__device__ __forceinline__ void phase_finish(const Ptrs& p, int l, int G, int wg) {
    const int tid = opq((int)threadIdx.x), lane = tid & 63, wave = tid >> 6;
    const f32x4 g0 = *(const f32x4*)(p.gdn_onorm_g + l * GDK + (lane & 15) * 8), g1 = *(const f32x4*)(p.gdn_onorm_g + l * GDK + (lane & 15) * 8 + 4);
    constexpr int PER = NR / (NWG * 8); static_assert(NR % (NWG * 8) == 0, "rows per wave");
    const int r0 = (wg * 8 + wave) * PER;
    FinRow cur, nxt; fin_load(cur, p, r0, lane);
    f32x4 lc[2][2]; int chunk_cur = -1;
#pragma unroll 1
    for (int k = 0; k < PER; ++k) { const int r = r0 + k;
        const int chunk = r < BX ? r / 64 : NXCH + (r - BX) / 64;
        fin_load(nxt, p, k + 1 < PER ? r + 1 : r, lane);
        if (chunk != chunk_cur) { chunk_cur = chunk;
#pragma unroll
            for (int d = 0; d < 2; ++d) { const size_t oc = ((size_t)d * NCHUNK + chunk) * LW + lane * 8; lc[d][0] = *(const f32x4*)(p.LSC_() + oc); lc[d][1] = *(const f32x4*)(p.LSC_() + oc + 4); } }
        { const f32x4 a = bf4((u32x2){cur.o0.x, cur.o0.y}) + bf4((u32x2){cur.o1.x, cur.o1.y}), b = bf4((u32x2){cur.o0.z, cur.o0.w}) + bf4((u32x2){cur.o1.z, cur.o1.w});
          float ss = a[0] * a[0] + a[1] * a[1] + a[2] * a[2] + a[3] * a[3] + b[0] * b[0] + b[1] * b[1] + b[2] * b[2] + b[3] * b[3];
          ss += shx(ss, 8, lane); ss += shx(ss, 4, lane); ss += shx(ss, 2, lane); ss += shx(ss, 1, lane);
          const float rs = __builtin_amdgcn_rsqf(ss * (1.0f / GDK) + EPS);
          const f32x4 z0 = bf4((u32x2){cur.zz.x, cur.zz.y}), z1 = bf4((u32x2){cur.zz.z, cur.zz.w});
          f32x4 y0 = a * rs * g0, y1 = b * rs * g1;
#pragma unroll
          for (int e = 0; e < 4; ++e) { y0[e] *= siluf_(z0[e]); y1[e] *= siluf_(z1[e]); }
          *(u32x4*)(p.BRb_() + (size_t)r * 3 * BW + lane * 8) = (u32x4){pk2(y0[0], y0[1]), pk2(y0[2], y0[3]), pk2(y1[0], y1[1]), pk2(y1[2], y1[3])}; }
        { f32x4 h0, h1;
#pragma unroll
          for (int e = 0; e < 4; ++e) {
              h0[e] = (__uint_as_float(cur.ha[0][0][e] << 16) + __uint_as_float(cur.ha[0][0][e] & 0xffff0000u) * lc[0][0][e]) + (__uint_as_float(cur.ha[1][0][e] << 16) + __uint_as_float(cur.ha[1][0][e] & 0xffff0000u) * lc[1][0][e]);
              h1[e] = (__uint_as_float(cur.ha[0][1][e] << 16) + __uint_as_float(cur.ha[0][1][e] & 0xffff0000u) * lc[0][1][e]) + (__uint_as_float(cur.ha[1][1][e] << 16) + __uint_as_float(cur.ha[1][1][e] & 0xffff0000u) * lc[1][1][e]); }
          const f32x4 y0 = bf4((u32x2){cur.yy.x, cur.yy.y}), y1 = bf4((u32x2){cur.yy.z, cur.yy.w});
#pragma unroll
          for (int e = 0; e < 4; ++e) { h0[e] *= geluf_(y0[e]); h1[e] *= geluf_(y1[e]); }
          *(u32x4*)(p.BRb_() + (size_t)r * 3 * BW + 2 * BW + lane * 8) = (u32x4){pk2(h0[0], h0[1]), pk2(h0[2], h0[3]), pk2(h1[0], h1[1]), pk2(h1[2], h1[3])}; }
        cur = nxt;
    }
}

#ifndef PROBE_MASK
#define PROBE_MASK 0
#endif
struct Args { Ptrs p; unsigned* bar; int ph_lo, ph_hi; };
#define STRIDE_LOOP(n, call) do { _Pragma("unroll 1") for (long g = (long)blockIdx.x * NTHREADS + opq((int)threadIdx.x); g < (long)(n); g += (long)NWG * NTHREADS) { call; } } while (0)
__global__ void __launch_bounds__(NTHREADS, 2) mega_fwd(Args a) {
    extern __shared__ __attribute__((aligned(16))) unsigned char lds_raw[];
    LAS unsigned char* lds = (LAS unsigned char*)lds_raw;
    Ptrs p = a.p, pn = a.p; constexpr int G = NWG; const int wg = blockIdx.x;
    volatile LAS unsigned* bst = (volatile LAS unsigned*)(lds + LDS_BAR_OFF);
    if (threadIdx.x == 0) { bst[0] = 0u; bst[1] = 0u; bst[2] = 0u; bst[3] = 0u; }
    __syncthreads();
    const XcdBarrier bar = xcd_barrier_post(a.bar, bst);
#define GRID_BAR() xcd_barrier(bar)
    phase_adaln(p, (LAS float*)lds, G, wg);
    GRID_BAR();
    for (int l = 0; l < DEPTH; ++l) { const bool last = l == DEPTH - 1; p.wofs = (l & 1) * WSET; pn.wofs = ((l + 1) & 1) * WSET;
        cvt_weights_small(p, l, G, wg);
        { const int tidq = opq((int)threadIdx.x), wv = tidq >> 6;
#pragma unroll 1
          for (int pass = 0; pass < 2; ++pass) {
              if ((pass == 0) == (wv < 4)) { for (int _r = 0; _r <= ((PROBE_MASK >> 0) & 1); ++_r) cvt_weights_wave(p, l, (LAS float*)lds + wv * (64 * 65), l == 0 ? 0 : CF_ALL, CT_ALL, wg * 8 + wv, G * 8, tidq & 63); }
              else phase_rows<MODE_N1>(p, l, (LAS float*)lds, G, wg); } }
        GRID_BAR();
        for (int _r = 0; _r <= ((PROBE_MASK >> 1) & 1); ++_r) {
        phase_gemm_in(p, lds, G, wg);
        }
        GRID_BAR();
        for (int _r = 0; _r <= ((PROBE_MASK >> 2) & 1); ++_r) {
        phase_gdn_local(p, l, lds, G, wg);
        }
        for (int _r = 0; _r <= ((PROBE_MASK >> 3) & 1); ++_r) {
        phase_swa_prep(p, l, G, wg);
        phase_lru_local(p, l, lds, G, wg);
        }
        GRID_BAR();
        if (wg < SCAN_WGS) {
            for (int _r = 0; _r <= ((PROBE_MASK >> 5) & 1); ++_r) phase_gdn_scan(p, lds, wg);
        } else {
            for (int _r = 0; _r <= ((PROBE_MASK >> 4) & 1); ++_r) phase_swa_attn(p, l, lds, G - SCAN_WGS, wg - SCAN_WGS, last);
#pragma unroll 1
            for (long g = (long)(G - 1 - (int)blockIdx.x) * NTHREADS + opq((int)threadIdx.x); g < (long)BATCH * 2 * LW; g += (long)G * NTHREADS) lru_carry_body(p, g);
        }
        GRID_BAR();
        for (int _r = 0; _r <= ((PROBE_MASK >> 6) & 1); ++_r) {
        phase_finish(p, l, G, wg);
        }
        GRID_BAR();
        for (int _r = 0; _r <= ((PROBE_MASK >> 7) & 1); ++_r) {
        phase_gemm_branch(p, lds, G, wg, last);
        }
        GRID_BAR();
        phase_gemm_out(p, pn, l, lds, G, wg, last);
        GRID_BAR();
        for (int _r = 0; _r <= ((PROBE_MASK >> 8) & 1); ++_r) {
        if (last) phase_rows<MODE_N2, true>(p, l, (LAS float*)lds, G, wg); else phase_rows<MODE_N2, false>(p, l, (LAS float*)lds, G, wg);
        }
        GRID_BAR();
        for (int _r = 0; _r <= ((PROBE_MASK >> 9) & 1); ++_r) {
        phase_rank(p, (LAS unsigned*)lds, G, wg, last);
        }
        GRID_BAR();
        for (int _r = 0; _r <= ((PROBE_MASK >> 10) & 1); ++_r) {
        phase_gemm_gu(p, lds, G, wg, last);
        }
        GRID_BAR();
        for (int _r = 0; _r <= ((PROBE_MASK >> 11) & 1); ++_r) {
        phase_gemm_down(p, pn, l, lds, G, wg, last);
        }
        GRID_BAR();
    }
    phase_rows<MODE_FINAL>(p, DEPTH, (LAS float*)lds, G, wg);
}

extern "C" void kernel_launch(void* const* d_in, const int* in_sizes, int n_in, void* d_out, int out_size, void* d_ws, size_t ws_size, hipStream_t stream) {
    Args a{}; Ptrs& p = a.p;
    const float** ins = (const float**)&p.x; for (int i = 0; i < 27; ++i) ins[i] = (const float*)d_in[i];
    p.out = (float*)d_out;
    p.ws = (char*)d_ws; p.wofs = 0; a.bar = (unsigned*)((char*)d_ws + O_bar); const size_t off = WS_END;
    if (off > ws_size) { fprintf(stderr, "kernel_launch: workspace too small: need %zu have %zu\n", off, ws_size); return; }
    (void)in_sizes; (void)n_in; (void)out_size;
    static int grid = 0;
    if (grid == 0) {
        int dev = 0, cus = 0, per_cu = 0;
        if (hipGetDevice(&dev) != hipSuccess || hipDeviceGetAttribute(&cus, hipDeviceAttributeMultiprocessorCount, dev) != hipSuccess || cus <= 0) { fprintf(stderr, "kernel_launch: device query failed\n"); grid = -1; return; }
        if (hipFuncSetAttribute((const void*)mega_fwd, hipFuncAttributeMaxDynamicSharedMemorySize, LDS_BYTES) != hipSuccess) { fprintf(stderr, "kernel_launch: hipFuncSetAttribute failed\n"); grid = -1; return; }
        if (hipOccupancyMaxActiveBlocksPerMultiprocessor(&per_cu, (const void*)mega_fwd, NTHREADS, LDS_BYTES) != hipSuccess || per_cu < 1) fprintf(stderr, "kernel_launch: occupancy query reports %d workgroups per CU\n", per_cu);
        (void)hipGetLastError();
        if (cus < NWG) { fprintf(stderr, "kernel_launch: built for a %d-CU device, found %d CUs; nothing launched\n", NWG, cus); grid = -1; return; }
        grid = NWG;
    }
    if (grid < 0) return;
    (void)hipMemsetAsync(a.bar, 0, (size_t)XCD_BAR_WORDS * 4, stream);
    a.ph_lo = 0; a.ph_hi = 1 << 30;
    hipLaunchKernelGGL(mega_fwd, dim3(grid), dim3(NTHREADS), LDS_BYTES, stream, a);
}
```

```cpp
#include <hip/hip_runtime.h>
#include <cstdio>
#include <utility>

constexpr int D_MODEL = 1024, BATCH = 8, SEQ = 2048, DEPTH = 4, CTX = 256, GH = 4, GDK = 128, QH = 8, KVH = 2, HD = 64, LW = 512, LB = 8, NE = 16, EH = 2048;
constexpr int GRID_W = 64, SWA_WINDOW = 128, ECAP = 2, NBR = 3;
constexpr int D = D_MODEL, BW = GH * GDK, SGRP = QH / KVH, LBW = LW / LB;
constexpr float EPS = 1e-6f;
constexpr int BX = BATCH * SEQ, BC = BATCH * CTX, NR = BX + BC, NCOND = BATCH + 1;
constexpr int C_Q = 0, C_K = BW, C_V = 2 * BW, C_Z = 3 * BW, C_A = 4 * BW, C_B = C_A + 2 * GH, C_SQ = C_B + 2 * GH, C_SK = C_SQ + QH * HD, C_SV = C_SK + KVH * HD,
              C_LX = C_SV + KVH * HD, C_LY = C_LX + LW, C_G = C_LY + LW, D_IN = C_G + NBR * D;
constexpr int LDP = 7168;
constexpr int CAPX = ECAP * SEQ / NE, CAPC = ECAP * CTX / NE, ME = BATCH * (CAPX + CAPC);
static_assert(C_G % 8 == 0 && BW == QH * HD && BW == LW && D_IN <= LDP && LDP % 256 == 0 && NR % 256 == 0 && ME % 256 == 0, "shapes");

typedef unsigned short bf16_t;
constexpr int NWG = 256  , NTHREADS = 512, LDS_BAR_OFF = 160 * 1024 - 256  , LDS_BYTES = 160 * 1024;
__device__ __forceinline__ float bf2f(bf16_t b) { return __uint_as_float(((unsigned)b) << 16); }
__device__ __forceinline__ bf16_t f2bf(float f) { unsigned u = __float_as_uint(f); u += 0x7FFFu + ((u >> 16) & 1u); return (bf16_t)(u >> 16); }

constexpr int XCD_BAR_WORDS_C = 3456, NCHUNK_C = (BX + BC) / 64, NPROB_C = NCHUNK_C * GH * 2;
constexpr size_t al256(size_t x) { return (x + 255) & ~(size_t)255; }
static_assert(NCHUNK_C > NWG && NCHUNK_C - NWG <= NWG / 2, "lru_local deals its second-round chunks to workgroups NWG/2..");
constexpr size_t O_bar = 0;
constexpr size_t O_X = O_bar + al256((size_t)XCD_BAR_WORDS_C * 4);
constexpr size_t O_MOD = O_X + al256((size_t)NR * D * 4);
constexpr size_t O_HXb = O_MOD + al256((size_t)DEPTH * NCOND * 6 * D * 4);
constexpr size_t O_Pb = O_HXb + al256((size_t)NR * D * 2);
constexpr size_t O_GFR = O_Pb + al256((size_t)NR * LDP * 2);
constexpr size_t O_GU = O_GFR + al256((size_t)NPROB_C * 56 * 1024);
constexpr size_t O_GEG = O_GU + al256((size_t)NPROB_C * 8192 * 4);
constexpr size_t O_GO = O_GEG + al256((size_t)(NPROB_C + 64) * 4);
constexpr size_t O_SQb = O_GO + al256((size_t)2 * NR * BW * 4);
constexpr size_t O_SKb = O_SQb + al256((size_t)NR * QH * HD * 2);
constexpr size_t O_LA = O_SKb + al256((size_t)NR * KVH * HD * 2);
constexpr size_t O_LH = O_LA + al256((size_t)2 * NR * LW * 4);
constexpr size_t O_LSA = O_LH + al256((size_t)2 * NR * LW * 4);
constexpr size_t O_LSH = O_LSA + al256((size_t)2 * NCHUNK_C * LW * 4);
constexpr size_t O_LSC = O_LSH + al256((size_t)2 * NCHUNK_C * LW * 4);
constexpr size_t O_BRb = O_LSC + al256((size_t)2 * NCHUNK_C * LW * 4);
constexpr size_t O_MIXb = O_BRb + al256((size_t)NR * 3 * BW * 2);
constexpr size_t O_AFF = O_MIXb + al256((size_t)NR * D * 2);
constexpr size_t O_RANK = O_AFF + al256((size_t)NR * NE * 4);
constexpr size_t O_IDX = O_RANK + al256((size_t)NR * NE * 4);
constexpr size_t O_HIDb = O_IDX + al256((size_t)NE * ME * 4);
constexpr size_t O_YSb = O_HIDb + al256((size_t)NE * ME * EH * 2);
constexpr size_t O_Wt_in = O_YSb + al256((size_t)NE * ME * D * 2);
constexpr size_t O_Wt_br = O_Wt_in + al256((size_t)LDP * D * 2);
constexpr size_t O_Wt_out = O_Wt_br + al256((size_t)NBR * D * BW * 2);
constexpr size_t O_Wt_gu = O_Wt_out + al256((size_t)D * D * 2);
constexpr size_t O_Wt_d = O_Wt_gu + al256((size_t)NE * 2 * EH * D * 2);
constexpr size_t WSET = O_Wt_d + al256((size_t)NE * D * EH * 2) - O_Wt_in;
constexpr size_t O_Wt_lg = O_Wt_in + 2 * WSET;
constexpr size_t O_BP = O_Wt_lg + al256((size_t)4 * LB * LBW * LBW * 2);
constexpr size_t O_OP = O_BP + al256((size_t)6 * BC * D * 2);
constexpr size_t WS_END = O_OP + al256((size_t)6 * BC * D * 4);
struct Ptrs {
    const float *x, *c, *ctx, *c_ctx, *w_ada, *b_ada, *norm1_g, *norm2_g, *w_in, *gdn_conv_w, *gdn_a_log, *gdn_dt_bias, *gdn_onorm_g, *swa_qnorm_g, *swa_knorm_g, *swa_sink,
        *lru_conv_w, *lru_conv_b, *lru_gate_w, *lru_gate_b, *lru_lambda, *w_branch, *w_out, *w_router, *w_exp_gate, *w_exp_up, *w_exp_down;
    float* out; char* ws; size_t wofs;
    __device__ __forceinline__ float* X_() const { return (float*)(ws + O_X); }
    __device__ __forceinline__ float* MOD_() const { return (float*)(ws + O_MOD); }
    __device__ __forceinline__ bf16_t* HXb_() const { return (bf16_t*)(ws + O_HXb); }
    __device__ __forceinline__ bf16_t* Pb_() const { return (bf16_t*)(ws + O_Pb); }
    __device__ __forceinline__ bf16_t* GFR_() const { return (bf16_t*)(ws + O_GFR); }
    __device__ __forceinline__ float* GU_() const { return (float*)(ws + O_GU); }
    __device__ __forceinline__ float* GEG_() const { return (float*)(ws + O_GEG); }
    __device__ __forceinline__ float* GO_() const { return (float*)(ws + O_GO); }
    __device__ __forceinline__ bf16_t* SQb_() const { return (bf16_t*)(ws + O_SQb); }
    __device__ __forceinline__ bf16_t* SKb_() const { return (bf16_t*)(ws + O_SKb); }
    __device__ __forceinline__ float* LA_() const { return (float*)(ws + O_LA); }
    __device__ __forceinline__ float* LH_() const { return (float*)(ws + O_LH); }
    __device__ __forceinline__ float* LSA_() const { return (float*)(ws + O_LSA); }
    __device__ __forceinline__ float* LSH_() const { return (float*)(ws + O_LSH); }
    __device__ __forceinline__ float* LSC_() const { return (float*)(ws + O_LSC); }
    __device__ __forceinline__ bf16_t* BRb_() const { return (bf16_t*)(ws + O_BRb); }
    __device__ __forceinline__ bf16_t* MIXb_() const { return (bf16_t*)(ws + O_MIXb); }
    __device__ __forceinline__ float* AFF_() const { return (float*)(ws + O_AFF); }
    __device__ __forceinline__ int* RANK_() const { return (int*)(ws + O_RANK); }
    __device__ __forceinline__ int* IDX_() const { return (int*)(ws + O_IDX); }
    __device__ __forceinline__ bf16_t* HIDb_() const { return (bf16_t*)(ws + O_HIDb); }
    __device__ __forceinline__ bf16_t* YSb_() const { return (bf16_t*)(ws + O_YSb); }
    __device__ __forceinline__ bf16_t* Wt_in_() const { return (bf16_t*)(ws + O_Wt_in + wofs); }
    __device__ __forceinline__ bf16_t* Wt_br_() const { return (bf16_t*)(ws + O_Wt_br + wofs); }
    __device__ __forceinline__ bf16_t* Wt_out_() const { return (bf16_t*)(ws + O_Wt_out + wofs); }
    __device__ __forceinline__ bf16_t* Wt_gu_() const { return (bf16_t*)(ws + O_Wt_gu + wofs); }
    __device__ __forceinline__ bf16_t* Wt_d_() const { return (bf16_t*)(ws + O_Wt_d + wofs); }
    __device__ __forceinline__ bf16_t* Wt_lg_() const { return (bf16_t*)(ws + O_Wt_lg); }
    __device__ __forceinline__ bf16_t* BP_() const { return (bf16_t*)(ws + O_BP); }
    __device__ __forceinline__ float* OP_() const { return (float*)(ws + O_OP); }
};

__device__ __forceinline__ float fexp(float x) { return __builtin_amdgcn_exp2f(x * 1.4426950408889634f); }
__device__ __forceinline__ float sigmoidf_(float x) { return __builtin_amdgcn_rcpf(1.0f + fexp(-x)); }
__device__ __forceinline__ float siluf_(float x) { return x * __builtin_amdgcn_rcpf(1.0f + fexp(-x)); }
__device__ __forceinline__ float softplusf_(float x) { return x > 20.f ? x : (x < -20.f ? expf(x) : log1pf(expf(x))); }
__device__ __forceinline__ float geluf_(float x) { const float t = 0.7978845608028654f * (x + 0.044715f * x * x * x); return x * __builtin_amdgcn_rcpf(1.0f + fexp(-2.0f * t)); }
__device__ __forceinline__ void row_info(int r, int& ci, int& t, int& len, int& base, int& b) {
    if (r < BX) { b = r / SEQ; t = r - b * SEQ; len = SEQ; base = b * SEQ; ci = b; }
    else { const int q = r - BX; b = q / CTX; t = q - b * CTX; len = CTX; base = BX + b * CTX; ci = BATCH; }
}
__device__ __forceinline__ float ldP(const Ptrs& p, long r, int c) { return bf2f(p.Pb_()[r * LDP + c]); }
__device__ __forceinline__ long opq(long v) { asm volatile("" : "+v"(v)); return v; }
__device__ __forceinline__ int opq(int v) { asm volatile("" : "+v"(v)); return v; }
__device__ __forceinline__ float zero_f() { float z; asm volatile("v_mov_b32 %0, 0" : "=v"(z)); return z; }

namespace pg8 {
#define PG8_LAS __attribute__((address_space(3)))
typedef short bf16x8 __attribute__((ext_vector_type(8)));
typedef float f32x4 __attribute__((ext_vector_type(4)));
typedef unsigned u32x4 __attribute__((ext_vector_type(4)));
typedef unsigned u32x2 __attribute__((ext_vector_type(2)));
constexpr int BM = 256, BK = 64, HALF = 128, HTB = HALF * BK * 2  , STAGE_BYTES = 8 * HTB, NXCD = 8, WGM = 8;
__device__ __forceinline__ int lds_byte(int r, int c) { const int st = (r >> 4) * 2 + (c >> 5), rr = r & 15, cc = c & 31, ob = rr * 64 + cc * 2; return st * 1024 + (ob ^ (((ob >> 9) & 1) << 5)); }
__device__ __forceinline__ void stage_rc(int b, int& R, int& C) { const int st = b / 1024, sb = b % 1024, swz = sb ^ (((sb >> 9) & 1) << 5); R = (st >> 1) * 16 + swz / 64; C = (st & 1) * 32 + (swz % 64) / 2; }
__device__ __forceinline__ int perm32(int rho) { const int n = rho >> 4, i = rho & 15; return 8 * (i >> 2) + 4 * n + (i & 3); }
struct Unit { int pm, pn, z, grow; const char* a; const char* b; };
struct Gemm { int lda, ldb, K; const PG8_LAS int* gtab; };
struct Order {
    int nM, nN, nwg, G, c;
    __device__ void init(int nM_, int nN_, int G_, int c_) { nM = nM_; nN = nN_; nwg = nM * nN; G = G_; c = c_; }
    __device__ bool tile(int i, int& pm, int& pn) const {
        const long L = (long)i * G + c; if (L >= nwg) return false;
        int wgid = (int)L; { const int q = nwg / NXCD, r = nwg % NXCD, xcd = wgid % NXCD, off = wgid / NXCD; wgid = (xcd < r ? xcd * (q + 1) : r * (q + 1) + (xcd - r) * q) + off; }
        const int nig = WGM * nN, gid = wgid / nig, fm = gid * WGM, gsz = (nM - fm) < WGM ? (nM - fm) : WGM;
        pm = fm + ((wgid % nig) % gsz); pn = (wgid % nig) / gsz; return true;
    }
};
typedef float f32x2c __attribute__((ext_vector_type(2))); typedef __bf16 bf16x2c __attribute__((ext_vector_type(2)));
__device__ __forceinline__ unsigned pk2f(float a, float b) { const f32x2c v = {a, b}; return __builtin_bit_cast(unsigned, __builtin_convertvector(v, bf16x2c)); }
__device__ __forceinline__ unsigned cvt_pk_bf16(float lo, float hi) { unsigned r; asm volatile("v_cvt_pk_bf16_f32 %0, %1, %2" : "=v"(r) : "v"(lo), "v"(hi)); return r; }

template <class Epi, class Sched, bool GATHER = false>
__device__ __forceinline__ void gemm_phase(PG8_LAS unsigned char* lds, const Gemm g, const Sched& S, const Epi& E) {
    const int tid = opq((int)threadIdx.x), wid = __builtin_amdgcn_readfirstlane(tid >> 6), lane = tid & 63, wr = wid >> 2, wc = wid & 3, fr = lane & 15, fq = lane >> 4;
    const int K = g.K, nt = K / BK;
    unsigned voffA[2], voffB[2]; int Rr[2], Cc[2];
#pragma unroll
    for (int i = 0; i < 2; ++i) { int R, C; stage_rc(tid * 16 + i * 8192, R, C); const int Rb = Epi::PERM ? ((R & ~31) + perm32(R & 31)) : R; Rr[i] = R; Cc[i] = C;
        voffA[i] = (unsigned)(R * g.lda + C) * 2u; voffB[i] = (unsigned)(Rb * g.ldb + C) * 2u; }
    const size_t kstep = (size_t)(BK * 2);
    const size_t hstepA = GATHER ? 0 : (size_t)HALF * g.lda * 2, hstepB = (size_t)HALF * g.ldb * 2;
    const unsigned ldsw = (unsigned)wid * 1024u;
    const int aoff = lds_byte(wr * 64 + fr, fq * 8), boff = lds_byte(wc * 32 + fr, fq * 8);
    unsigned vC[2][2], vN[2][2];
#define PG8_GOFF(dst, ord) do { _Pragma("unroll") for (int _h = 0; _h < 2; ++_h) _Pragma("unroll") for (int _i = 0; _i < 2; ++_i) \
        dst[_h][_i] = ((unsigned)g.gtab[(ord) * BM + _h * HALF + Rr[_i]] * (unsigned)g.lda + (unsigned)Cc[_i]) * 2u; } while (0)
#define PG8_SA(b, h) (((b) * 2 + (h)) * HTB)
#define PG8_SB(b, h) ((4 + (b) * 2 + (h)) * HTB)
#define PG8_STAGE(bufoff, gbase, voff) do { _Pragma("unroll") for (int _i = 0; _i < 2; ++_i) \
        __builtin_amdgcn_global_load_lds((const unsigned*)((const char*)(gbase) + (voff)[_i]), (PG8_LAS unsigned*)(lds + (bufoff) + ldsw + _i * 8192), 16, 0, 0); } while (0)
#define PG8_STAGE_A(bufoff, kptr, h, nx) do { if constexpr (GATHER) { _Pragma("unroll") for (int _i = 0; _i < 2; ++_i) { const unsigned _o = (nx) ? vN[h][_i] : vC[h][_i]; \
            __builtin_amdgcn_global_load_lds((const unsigned*)((const char*)(kptr) + _o), (PG8_LAS unsigned*)(lds + (bufoff) + ldsw + _i * 8192), 16, 0, 0); } } \
        else PG8_STAGE(bufoff, (kptr) + (h) * hstepA, voffA); } while (0)
#define PG8_LDA(dst, b, h) do { _Pragma("unroll") for (int m = 0; m < 4; ++m) _Pragma("unroll") for (int k = 0; k < 2; ++k) dst[m][k] = *(const PG8_LAS bf16x8*)(lds + PG8_SA(b, h) + aoff + m * 2048 + k * 1024); } while (0)
#define PG8_LDB(dst, b, h) do { _Pragma("unroll") for (int n = 0; n < 2; ++n) _Pragma("unroll") for (int k = 0; k < 2; ++k) dst[n][k] = *(const PG8_LAS bf16x8*)(lds + PG8_SB(b, h) + boff + n * 2048 + k * 1024); } while (0)
#define PG8_MMA(ai, bj, At, Bt) do { __builtin_amdgcn_s_setprio(1); _Pragma("unroll") for (int m = 0; m < 4; ++m) _Pragma("unroll") for (int n = 0; n < 2; ++n) _Pragma("unroll") for (int k = 0; k < 2; ++k) \
        acc[ai][bj][m][n] = __builtin_amdgcn_mfma_f32_16x16x32_bf16(Bt[n][k], At[m][k], acc[ai][bj][m][n], 0, 0, 0); __builtin_amdgcn_s_setprio(0); } while (0)
#define PG8_WAIT_V(n) asm volatile("s_waitcnt vmcnt(" #n ")" ::: "memory")
#define PG8_WAIT_L(n) asm volatile("s_waitcnt lgkmcnt(" #n ")" ::: "memory")
#define PG8_BAR __builtin_amdgcn_s_barrier()
#define PG8_SCHED __builtin_amdgcn_sched_barrier(0)
    Unit cur, nxt; int ui = 0;
    if (!S.next(0, cur)) return;
    f32x4 acc[2][2][4][2];
    { const float z = zero_f();
#pragma unroll
    for (int a = 0; a < 2; ++a)
#pragma unroll
        for (int b = 0; b < 2; ++b)
#pragma unroll
            for (int m = 0; m < 4; ++m)
#pragma unroll
                for (int n = 0; n < 2; ++n) acc[a][b][m][n] = (f32x4){z, z, z, z}; }
    bf16x8 At[4][2], B0[2][2], B1[2][2];
    const char* cA = cur.a; const char* cB = cur.b;
    if constexpr (GATHER) { PG8_GOFF(vC, 0); }
    PG8_STAGE(PG8_SB(0, 0), cB, voffB); PG8_STAGE(PG8_SB(0, 1), cB + hstepB, voffB); PG8_STAGE_A(PG8_SA(0, 0), cA, 0, false); PG8_STAGE_A(PG8_SA(0, 1), cA, 1, false);
    if (wr == 1) PG8_BAR;
    PG8_WAIT_V(2); PG8_BAR;
    PG8_STAGE(PG8_SB(1, 0), cB + kstep, voffB); PG8_STAGE_A(PG8_SA(1, 0), cA + kstep, 0, false); PG8_STAGE(PG8_SB(1, 1), cB + hstepB + kstep, voffB);
    PG8_WAIT_V(6); PG8_BAR;
    for (;;) {
        const bool has_next = S.next(ui + 1, nxt);
        const char* nA = has_next ? nxt.a : cA; const char* nB = has_next ? nxt.b : cB;
        if constexpr (GATHER) { if (has_next) { PG8_GOFF(vN, ui + 1); } else {
#pragma unroll
            for (int h = 0; h < 2; ++h)
#pragma unroll
                for (int i = 0; i < 2; ++i) vN[h][i] = vC[h][i]; } }
#pragma unroll 1
        for (int t = 0; t < nt; t += 2) {
            const bool last = (t == nt - 2);
            const char* a1 = cA + (size_t)(t + 1) * kstep;
            const char* a2 = last ? nA : cA + (size_t)(t + 2) * kstep; const char* b2 = last ? nB : cB + (size_t)(t + 2) * kstep;
            const char* a3 = a2 + kstep; const char* b3 = b2 + kstep;
            PG8_LDB(B0, 0, 0); PG8_LDB(B1, 0, 1); PG8_SCHED; PG8_LDA(At, 0, 0); PG8_STAGE_A(PG8_SA(1, 1), a1, 1, false);
            PG8_WAIT_V(8); PG8_WAIT_L(0); PG8_BAR; PG8_MMA(0, 0, At, B0); PG8_MMA(0, 1, At, B1); PG8_BAR; PG8_SCHED;
            PG8_LDA(At, 0, 1); PG8_STAGE(PG8_SB(0, 0), b2, voffB); PG8_STAGE(PG8_SB(0, 1), b2 + hstepB, voffB); PG8_STAGE_A(PG8_SA(0, 0), a2, 0, last);
            PG8_WAIT_V(8); PG8_WAIT_L(0); PG8_BAR; PG8_MMA(1, 0, At, B0); PG8_MMA(1, 1, At, B1); PG8_BAR; PG8_SCHED;
            PG8_LDB(B0, 1, 0); PG8_LDB(B1, 1, 1); PG8_SCHED; PG8_LDA(At, 1, 0); PG8_STAGE_A(PG8_SA(0, 1), a2, 1, last);
            PG8_WAIT_V(8); PG8_WAIT_L(0); PG8_BAR; PG8_MMA(0, 0, At, B0); PG8_MMA(0, 1, At, B1); PG8_BAR; PG8_SCHED;
            PG8_LDA(At, 1, 1); PG8_STAGE(PG8_SB(1, 0), b3, voffB); PG8_STAGE(PG8_SB(1, 1), b3 + hstepB, voffB); PG8_STAGE_A(PG8_SA(1, 0), a3, 0, last);
            PG8_WAIT_V(8); PG8_WAIT_L(0); PG8_BAR; PG8_MMA(1, 0, At, B0); PG8_MMA(1, 1, At, B1); PG8_BAR; PG8_SCHED;
        }
        if (wr == 0) PG8_BAR;
        E(acc, cur, wr, wc, fr, fq);
        if (!has_next) break;
        if (!E.keep(cur)) { const float z = zero_f();
#pragma unroll
        for (int a = 0; a < 2; ++a)
#pragma unroll
            for (int b = 0; b < 2; ++b)
#pragma unroll
                for (int m = 0; m < 4; ++m)
#pragma unroll
                    for (int n = 0; n < 2; ++n) acc[a][b][m][n] = (f32x4){z, z, z, z};
        }
        cur = nxt; cA = nA; cB = nB; ++ui;
        if constexpr (GATHER) {
#pragma unroll
            for (int h = 0; h < 2; ++h)
#pragma unroll
                for (int i = 0; i < 2; ++i) vC[h][i] = vN[h][i]; }
        if (wr == 1) PG8_BAR;
    }
    PG8_WAIT_V(0);
    PG8_BAR;
#undef PG8_GOFF
#undef PG8_SA
#undef PG8_SB
#undef PG8_STAGE
#undef PG8_STAGE_A
#undef PG8_LDA
#undef PG8_LDB
#undef PG8_MMA
#undef PG8_WAIT_V
#undef PG8_WAIT_L
#undef PG8_BAR
#undef PG8_SCHED
}
}
using pg8::f32x4; using pg8::u32x4; using pg8::u32x2; using pg8::Unit; using pg8::cvt_pk_bf16;
#define LAS __attribute__((address_space(3)))
__device__ __forceinline__ f32x4 bf4(u32x2 w) { f32x4 r; r[0] = __uint_as_float(w.x << 16); r[1] = __uint_as_float(w.x & 0xffff0000u); r[2] = __uint_as_float(w.y << 16); r[3] = __uint_as_float(w.y & 0xffff0000u); return r; }

struct SchedPlain : pg8::Order { const char* A; const char* B; size_t sa, sb;
    __device__ bool next(int i, Unit& u) const { if (!tile(i, u.pm, u.pn)) return false; u.z = 0; u.grow = 0; u.a = A + (size_t)u.pm * sa; u.b = B + (size_t)u.pn * sb; return true; } };
struct SchedBranch : pg8::Order { const char* A; const char* B;
    __device__ bool next(int i, Unit& u) const { if (!tile(i / NBR, u.pm, u.pn)) return false; u.z = i % NBR; u.grow = 0;
        u.a = A + ((size_t)u.pm * 256 * (NBR * BW) + (size_t)u.z * BW) * 2; u.b = B + ((size_t)u.z * D * BW + (size_t)u.pn * 256 * BW) * 2; return true; } };
struct SchedExpert : pg8::Order { const char* A; const char* B; size_t sa, sb, sbz; int tpe;
    __device__ bool next(int i, Unit& u) const { if (!tile(i, u.pm, u.pn)) return false; u.z = u.pm / tpe; u.pm = u.z * (ME / 256) + u.pm % tpe; u.grow = u.pm * 256; u.a = A + (size_t)u.pm * sa; u.b = B + (size_t)u.z * sbz + (size_t)u.pn * sb; return true; } };

struct EpiStoreBf16 {
    static constexpr bool PERM = true; bf16_t* O; int ldc;
    __device__ __forceinline__ bool keep(const Unit&) const { return false; }
    __device__ __forceinline__ void operator()(const f32x4 (&acc)[2][2][4][2], const Unit& u, int wr, int wc, int fr, int fq) const {
        const int row0 = u.pm * 256 + wr * 64 + fr, col0 = u.pn * 256 + wc * 32 + 8 * fq;
#pragma unroll
        for (int ai = 0; ai < 2; ++ai)
#pragma unroll
            for (int m = 0; m < 4; ++m) { bf16_t* rowp = O + (size_t)(row0 + ai * 128 + m * 16) * ldc + col0;
#pragma unroll
                for (int bj = 0; bj < 2; ++bj) { const f32x4 v0 = acc[ai][bj][m][0], v1 = acc[ai][bj][m][1];
                    u32x4 w; w.x = cvt_pk_bf16(v0[0], v0[1]); w.y = cvt_pk_bf16(v0[2], v0[3]); w.z = cvt_pk_bf16(v1[0], v1[1]); w.w = cvt_pk_bf16(v1[2], v1[3]);
                    *(u32x4*)(rowp + bj * 128) = w; } }
    }
};
struct EpiInProj {
    static constexpr bool PERM = true; bf16_t* O;
    __device__ __forceinline__ bool keep(const Unit&) const { return false; }
    __device__ __forceinline__ void operator()(const f32x4 (&acc)[2][2][4][2], const Unit& u, int wr, int wc, int fr, int fq) const {
        const int row0 = u.pm * 256 + wr * 64 + fr, col0 = u.pn * 256 + wc * 32 + 8 * fq; const bool gates = u.pn * 256 + 256 > C_G;
#pragma unroll
        for (int ai = 0; ai < 2; ++ai)
#pragma unroll
            for (int m = 0; m < 4; ++m) { bf16_t* rowp = O + (size_t)(row0 + ai * 128 + m * 16) * LDP + col0;
#pragma unroll
                for (int bj = 0; bj < 2; ++bj) { f32x4 v0 = acc[ai][bj][m][0], v1 = acc[ai][bj][m][1];
                    if (gates && col0 + bj * 128 >= C_G) {
#pragma unroll
                        for (int e = 0; e < 4; ++e) { v0[e] = sigmoidf_(fminf(fmaxf(v0[e], -30.f), 30.f)); v1[e] = sigmoidf_(fminf(fmaxf(v1[e], -30.f), 30.f)); } }
                    u32x4 w; w.x = cvt_pk_bf16(v0[0], v0[1]); w.y = cvt_pk_bf16(v0[2], v0[3]); w.z = cvt_pk_bf16(v1[0], v1[1]); w.w = cvt_pk_bf16(v1[2], v1[3]);
                    *(u32x4*)(rowp + bj * 128) = w; } }
    }
};
struct EpiBranch {
    static constexpr bool PERM = true; bf16_t* MIXb; const bf16_t* Pb;
    __device__ __forceinline__ bool keep(const Unit& u) const { return u.z < NBR - 1; }
    __device__ __forceinline__ void operator()(f32x4 (&acc)[2][2][4][2], const Unit& u, int wr, int wc, int fr, int fq) const {
        const int row0 = u.pm * 256 + wr * 64 + fr, col0 = u.pn * 256 + wc * 32 + 8 * fq; const bool mid = u.z < NBR - 1;
#pragma unroll
        for (int ai = 0; ai < 2; ++ai) {
            u32x4 g[4][2], h[4][2];
#pragma unroll
            for (int m = 0; m < 4; ++m)
#pragma unroll
                for (int bj = 0; bj < 2; ++bj) { const bf16_t* gp = Pb + (size_t)(row0 + ai * 128 + m * 16) * LDP + C_G + u.z * D + col0 + bj * 128; g[m][bj] = *(const u32x4*)gp; h[m][bj] = *(const u32x4*)(gp + (mid ? D : 0)); }
            __builtin_amdgcn_sched_barrier(0);
#pragma unroll
            for (int m = 0; m < 4; ++m)
#pragma unroll
                for (int bj = 0; bj < 2; ++bj) { f32x4 s0 = bf4((u32x2){g[m][bj].x, g[m][bj].y}), s1 = bf4((u32x2){g[m][bj].z, g[m][bj].w});
                    if (mid) { const f32x4 d0 = bf4((u32x2){h[m][bj].x, h[m][bj].y}), d1 = bf4((u32x2){h[m][bj].z, h[m][bj].w});
#pragma unroll
                        for (int e = 0; e < 4; ++e) { s0[e] *= __builtin_amdgcn_rcpf(d0[e]); s1[e] *= __builtin_amdgcn_rcpf(d1[e]); } }
                    acc[ai][bj][m][0] *= s0; acc[ai][bj][m][1] *= s1; }
            if (!mid) {
#pragma unroll
                for (int m = 0; m < 4; ++m)
#pragma unroll
                    for (int bj = 0; bj < 2; ++bj) { const f32x4 v0 = acc[ai][bj][m][0], v1 = acc[ai][bj][m][1];
                        *(u32x4*)(MIXb + (size_t)(row0 + ai * 128 + m * 16) * D + col0 + bj * 128) = (u32x4){cvt_pk_bf16(v0[0], v0[1]), cvt_pk_bf16(v0[2], v0[3]), cvt_pk_bf16(v1[0], v1[1]), cvt_pk_bf16(v1[2], v1[3])}; } }
        }
    }
};
struct EpiOut {
    static constexpr bool PERM = false; float* X; const float* mod;
    __device__ __forceinline__ bool keep(const Unit&) const { return false; }
    __device__ __forceinline__ void operator()(const f32x4 (&acc)[2][2][4][2], const Unit& u, int wr, int wc, int fr, int fq) const {
        const int row0 = u.pm * 256 + wr * 64 + fr, col0 = u.pn * 256 + wc * 32 + 4 * fq;
        const int rt = u.pm * 256; const int ci = rt < BX ? rt / SEQ : BATCH;
        const float* g1 = mod + (size_t)ci * 6 * D + 2 * D;
        f32x4 gv[2][2];
#pragma unroll
        for (int bj = 0; bj < 2; ++bj)
#pragma unroll
            for (int n = 0; n < 2; ++n) gv[bj][n] = *(const f32x4*)(g1 + col0 + bj * 128 + n * 16);
#pragma unroll
        for (int ai = 0; ai < 2; ++ai) {
            f32x4 xv[4][2][2];
#pragma unroll
            for (int m = 0; m < 4; ++m)
#pragma unroll
                for (int bj = 0; bj < 2; ++bj)
#pragma unroll
                    for (int n = 0; n < 2; ++n) xv[m][bj][n] = *(const f32x4*)(X + (size_t)(row0 + ai * 128 + m * 16) * D + col0 + bj * 128 + n * 16);
            __builtin_amdgcn_sched_barrier(0);
#pragma unroll
            for (int m = 0; m < 4; ++m)
#pragma unroll
                for (int bj = 0; bj < 2; ++bj)
#pragma unroll
                    for (int n = 0; n < 2; ++n) *(f32x4*)(X + (size_t)(row0 + ai * 128 + m * 16) * D + col0 + bj * 128 + n * 16) = xv[m][bj][n] + gv[bj][n] * acc[ai][bj][m][n];
        }
    }
};
struct SchedBrCtx { int wg; const char* A; const char* B;
    __device__ bool next(int i, Unit& u) const { if (i > 0 || wg >= (BC / 256) * (D / 256) * NBR * 2) return false; const int t = wg / (NBR * 2), rem = wg % (NBR * 2); u.z = rem >> 1; u.grow = rem & 1;
        u.pm = BX / 256 + t / (D / 256); u.pn = t % (D / 256);
        u.a = A + ((size_t)u.pm * 256 * (NBR * BW) + (size_t)u.z * BW + (size_t)u.grow * (BW / 2)) * 2; u.b = B + ((size_t)u.z * D * BW + (size_t)u.pn * 256 * BW + (size_t)u.grow * (BW / 2)) * 2; return true; } };
struct EpiBrCtx {
    static constexpr bool PERM = true; bf16_t* BP; const bf16_t* Pb;
    __device__ __forceinline__ bool keep(const Unit&) const { return false; }
    __device__ __forceinline__ void operator()(const f32x4 (&acc)[2][2][4][2], const Unit& u, int wr, int wc, int fr, int fq) const {
        const int row0 = u.pm * 256 + wr * 64 + fr, col0 = u.pn * 256 + wc * 32 + 8 * fq; bf16_t* O = BP + (size_t)(u.z * 2 + u.grow) * BC * D;
        u32x4 g[2][4][2];
#pragma unroll
        for (int ai = 0; ai < 2; ++ai)
#pragma unroll
            for (int m = 0; m < 4; ++m)
#pragma unroll
                for (int bj = 0; bj < 2; ++bj) g[ai][m][bj] = *(const u32x4*)(Pb + (size_t)(row0 + ai * 128 + m * 16) * LDP + C_G + u.z * D + col0 + bj * 128);
        __builtin_amdgcn_sched_barrier(0);
#pragma unroll
        for (int ai = 0; ai < 2; ++ai)
#pragma unroll
            for (int m = 0; m < 4; ++m) { const size_t row = (size_t)(row0 + ai * 128 + m * 16);
#pragma unroll
                for (int bj = 0; bj < 2; ++bj) { const int col = col0 + bj * 128; const u32x4 gg = g[ai][m][bj];
                    const f32x4 v0 = acc[ai][bj][m][0] * bf4((u32x2){gg.x, gg.y}), v1 = acc[ai][bj][m][1] * bf4((u32x2){gg.z, gg.w});
                    *(u32x4*)(O + (row - BX) * D + col) = (u32x4){cvt_pk_bf16(v0[0], v0[1]), cvt_pk_bf16(v0[2], v0[3]), cvt_pk_bf16(v1[0], v1[1]), cvt_pk_bf16(v1[2], v1[3])}; } }
    }
};
struct SchedOutCtx { int wg; const char* A; const char* B;
    __device__ bool next(int i, Unit& u) const { if (i > 0 || wg >= (BC / 256) * (D / 256) * 2 * NBR) return false; const int t = wg / (2 * NBR); u.grow = wg % (2 * NBR); u.z = 0;
        u.pm = BX / 256 + t / (D / 256); u.pn = t % (D / 256);
        u.a = A + ((size_t)u.grow * BC * D + (size_t)(u.pm * 256 - BX) * D) * 2; u.b = B + (size_t)u.pn * 256 * D * 2; return true; } };
struct EpiOutCtx {
    static constexpr bool PERM = true; bf16_t* OP;
    __device__ __forceinline__ bool keep(const Unit&) const { return false; }
    __device__ __forceinline__ void operator()(const f32x4 (&acc)[2][2][4][2], const Unit& u, int wr, int wc, int fr, int fq) const {
        const int row0 = u.pm * 256 + wr * 64 + fr - BX, col0 = u.pn * 256 + wc * 32 + 8 * fq; bf16_t* O = OP + (size_t)u.grow * BC * D;
#pragma unroll
        for (int ai = 0; ai < 2; ++ai)
#pragma unroll
            for (int m = 0; m < 4; ++m) { bf16_t* rowp = O + (size_t)(row0 + ai * 128 + m * 16) * D + col0;
#pragma unroll
                for (int bj = 0; bj < 2; ++bj) { const f32x4 v0 = acc[ai][bj][m][0], v1 = acc[ai][bj][m][1];
                    u32x4 w; w.x = cvt_pk_bf16(v0[0], v0[1]); w.y = cvt_pk_bf16(v0[2], v0[3]); w.z = cvt_pk_bf16(v1[0], v1[1]); w.w = cvt_pk_bf16(v1[2], v1[3]);
                    *(u32x4*)(rowp + bj * 128) = w; } }
    }
};
struct EpiSwiglu {
    static constexpr bool PERM = true; bf16_t* H;
    __device__ __forceinline__ bool keep(const Unit&) const { return false; }
    __device__ __forceinline__ void operator()(const f32x4 (&acc)[2][2][4][2], const Unit& u, int wr, int wc, int fr, int fq) const {
        const int row0 = u.pm * 256 + wr * 64 + fr, col0 = u.pn * 128 + wc * 32 + 8 * fq;
#pragma unroll
        for (int ai = 0; ai < 2; ++ai)
#pragma unroll
            for (int m = 0; m < 4; ++m) { bf16_t* rowp = H + (size_t)(row0 + ai * 128 + m * 16) * EH + col0;
                f32x4 h0, h1;
#pragma unroll
                for (int j = 0; j < 4; ++j) { h0[j] = siluf_(acc[ai][0][m][0][j]) * acc[ai][1][m][0][j]; h1[j] = siluf_(acc[ai][0][m][1][j]) * acc[ai][1][m][1][j]; }
                u32x4 w; w.x = cvt_pk_bf16(h0[0], h0[1]); w.y = cvt_pk_bf16(h0[2], h0[3]); w.z = cvt_pk_bf16(h1[0], h1[1]); w.w = cvt_pk_bf16(h1[2], h1[3]);
                *(u32x4*)rowp = w; }
    }
};

__device__ __forceinline__ void cvt_tile_wave(const float* src, int N, int k0, int n0, bf16_t* dst, int ldd, int rowmode, LAS float* tile, int lane) {
    { const int kk = lane >> 4, n4 = (lane & 15) * 4; const bool ok = n0 + n4 < N; const float* sp = src + (size_t)(k0 + kk) * N + (ok ? n0 + n4 : 0);
      f32x4 v[16];
#pragma unroll
      for (int j = 0; j < 16; ++j) v[j] = *(const f32x4*)(sp + (size_t)(4 * j) * N);
      __builtin_amdgcn_sched_barrier(0);
#pragma unroll
      for (int j = 0; j < 16; ++j) { LAS float* tp = tile + (kk + 4 * j) * 65 + n4; tp[0] = ok ? v[j][0] : 0.f; tp[1] = ok ? v[j][1] : 0.f; tp[2] = ok ? v[j][2] : 0.f; tp[3] = ok ? v[j][3] : 0.f; } }
    { const int nl = lane >> 3, k8 = (lane & 7) * 8;
#pragma unroll
      for (int hf = 0; hf < 2; ++hf) { float tv[4][8];
#pragma unroll
          for (int q = 0; q < 4; ++q) { const LAS float* tp = tile + k8 * 65 + (hf * 4 + q) * 8 + nl;
#pragma unroll
              for (int e = 0; e < 8; ++e) tv[q][e] = tp[e * 65]; }
          __builtin_amdgcn_sched_barrier(0);
#pragma unroll
          for (int q = 0; q < 4; ++q) { const int n = (hf * 4 + q) * 8 + nl, ng = n0 + n;
              if (ng < N) { const int row = rowmode == 0 ? ng : (ng >> 7) * 256 + (rowmode == 2 ? 128 : 0) + (ng & 127);
                  *(u32x4*)(dst + (size_t)row * ldd + k0 + k8) = (u32x4){pg8::pk2f(tv[q][0], tv[q][1]), pg8::pk2f(tv[q][2], tv[q][3]), pg8::pk2f(tv[q][4], tv[q][5]), pg8::pk2f(tv[q][6], tv[q][7])}; } } } }
}
constexpr int CT_IN = (D / 64) * ((D_IN + 63) / 64), CT_BR = NBR * (BW / 64) * (D / 64), CT_OUT = (D / 64) * (D / 64), CT_GU = 2 * NE * (D / 64) * (EH / 64), CT_D = NE * (EH / 64) * (D / 64), CT_ALL = CT_IN + CT_BR + CT_OUT + CT_GU + CT_D;
__device__ __forceinline__ void cvt_weights_wave(const Ptrs& p, int l, LAS float* tile, int tbeg, int tend, int gw, int nw, int lane) {
#pragma unroll 1
    for (int t = tbeg + gw; t < tend; t += nw) {
        if (t < CT_IN) { const int nk = D / 64; cvt_tile_wave(p.w_in + (size_t)l * D * D_IN, D_IN, (t % nk) * 64, (t / nk) * 64, p.Wt_in_(), D, 0, tile, lane); }
        else if (t < CT_IN + CT_BR) { const int u = t - CT_IN, nk = BW / 64, per = nk * (D / 64), z = u / per, v = u % per;
            cvt_tile_wave(p.w_branch + ((size_t)l * NBR + z) * BW * D, D, (v % nk) * 64, (v / nk) * 64, p.Wt_br_() + (size_t)z * D * BW, BW, 0, tile, lane); }
        else if (t < CT_IN + CT_BR + CT_OUT) { const int u = t - CT_IN - CT_BR, nk = D / 64; cvt_tile_wave(p.w_out + (size_t)l * D * D, D, (u % nk) * 64, (u / nk) * 64, p.Wt_out_(), D, 0, tile, lane); }
        else if (t < CT_IN + CT_BR + CT_OUT + CT_GU) { const int u = t - CT_IN - CT_BR - CT_OUT, nk = D / 64, per = nk * (EH / 64), which = u / (NE * per), e = (u / per) % NE, v = u % per;
            cvt_tile_wave((which ? p.w_exp_up : p.w_exp_gate) + ((size_t)l * NE + e) * D * EH, EH, (v % nk) * 64, (v / nk) * 64, p.Wt_gu_() + (size_t)e * 2 * EH * D, D, 1 + which, tile, lane); }
        else { const int u = t - CT_IN - CT_BR - CT_OUT - CT_GU, nk = EH / 64, per = nk * (D / 64), e = u / per, v = u % per;
            cvt_tile_wave(p.w_exp_down + ((size_t)l * NE + e) * EH * D, D, (v % nk) * 64, (v / nk) * 64, p.Wt_d_() + (size_t)e * D * EH, EH, 0, tile, lane); }
    }
}
constexpr int CF_DOWN = (NWG - 64) * 8 * 6, CF_OUT = (NWG - 192) * 8 * 6, CF_ALL = CF_DOWN + CF_OUT;
static_assert(CF_ALL < CT_ALL && NE * (ME / 256) * (D / 256) - 2 * NWG == 64 && (BC / 256) * (D / 256) * 2 * NBR == 192, "filler shares follow the unit counts");
__device__ __forceinline__ void cvt_weights_small(const Ptrs& p, int l, int G, int wg) {
    const int nz = (LDP - D_IN) * D / 8;
#pragma unroll 1
    for (int i = wg * 512 + opq((int)threadIdx.x); i < nz; i += G * 512) { const unsigned z = __float_as_uint(zero_f()); *(u32x4*)(p.Wt_in_() + (size_t)D_IN * D + (size_t)i * 8) = (u32x4){z, z, z, z}; }
#pragma unroll 1
    for (int i = wg * 512 + opq((int)threadIdx.x); i < 4 * LB * LBW * LBW; i += G * 512) { const int ii = i % LBW, j = (i / LBW) % LBW, blk = i / (LBW * LBW);
        p.Wt_lg_()[i] = f2bf(p.lru_gate_w[(size_t)l * 4 * LB * LBW * LBW + ((size_t)blk * LBW + ii) * LBW + j]); }
}
__device__ __forceinline__ void phase_gemm_in(const Ptrs& p, LAS unsigned char* lds, int G, int wg) {
    SchedPlain S; S.init(NR / 256, LDP / 256, G, wg); S.A = (const char*)p.HXb_(); S.B = (const char*)p.Wt_in_(); S.sa = (size_t)256 * D * 2; S.sb = (size_t)256 * D * 2;
    pg8::gemm_phase(lds, pg8::Gemm{D, D, D, nullptr}, S, EpiInProj{p.Pb_()});
}
__device__ __forceinline__ void phase_gemm_branch(const Ptrs& p, LAS unsigned char* lds, int G, int wg, bool xonly) {
    SchedBranch S; S.init(BX / 256, D / 256, G, wg); S.A = (const char*)p.BRb_(); S.B = (const char*)p.Wt_br_();
    pg8::gemm_phase(lds, pg8::Gemm{NBR * BW, BW, BW, nullptr}, S, EpiBranch{p.MIXb_(), p.Pb_()});
    if (!xonly) { SchedBrCtx C; C.wg = wg; C.A = (const char*)p.BRb_(); C.B = (const char*)p.Wt_br_();
        pg8::gemm_phase(lds, pg8::Gemm{NBR * BW, BW, BW / 2, nullptr}, C, EpiBrCtx{p.BP_(), p.Pb_()}); }
}
__device__ __forceinline__ void phase_gemm_out(const Ptrs& p, const Ptrs& pn, int l, LAS unsigned char* lds, int G, int wg, bool xonly) {
    SchedPlain S; S.init(BX / 256, D / 256, G, wg); S.A = (const char*)p.MIXb_(); S.B = (const char*)p.Wt_out_(); S.sa = (size_t)256 * D * 2; S.sb = (size_t)256 * D * 2;
    pg8::gemm_phase(lds, pg8::Gemm{D, D, D, nullptr}, S, EpiOut{p.X_(), p.MOD_() + (size_t)l * NCOND * 6 * D});
    if (!xonly) { SchedOutCtx C; C.wg = wg; C.A = (const char*)p.BP_(); C.B = (const char*)p.Wt_out_();
        pg8::gemm_phase(lds, pg8::Gemm{D, D, D, nullptr}, C, EpiOutCtx{(bf16_t*)p.OP_()});
        if (wg >= 192) { const int tidq = opq((int)threadIdx.x), wv = tidq >> 6; cvt_weights_wave(pn, l + 1, (LAS float*)lds + wv * (64 * 65), CF_DOWN, CF_ALL, (wg - 192) * 8 + wv, (NWG - 192) * 8, tidq & 63); } }
}
__device__ __forceinline__ void phase_gemm_gu(const Ptrs& p, LAS unsigned char* lds, int G, int wg, bool xonly) {
    SchedExpert S; S.tpe = xonly ? BATCH * CAPX / 256 : ME / 256; S.init(NE * S.tpe, 2 * EH / 256, G, wg); S.A = (const char*)p.HXb_(); S.B = (const char*)p.Wt_gu_(); S.sa = 0; S.sb = (size_t)256 * D * 2; S.sbz = (size_t)2 * EH * D * 2;
    LAS int* gtab = (LAS int*)(lds + pg8::STAGE_BYTES);
    { Unit u; u.grow = 0; const int tid = opq((int)threadIdx.x); constexpr int MAXU = (NE * (ME / 256) * (2 * EH / 256) + NWG - 1) / NWG;
      int gv[MAXU]; bool gok[MAXU];
#pragma unroll
      for (int i = 0; i < MAXU; ++i) { gok[i] = S.next(i, u); gv[i] = p.IDX_()[u.grow + (tid & 255)]; }
      __builtin_amdgcn_sched_barrier(0);
#pragma unroll
      for (int i = 0; i < MAXU; ++i) if (gok[i] && tid < 256) gtab[i * 256 + tid] = gv[i]; }
    __syncthreads();
    pg8::gemm_phase<EpiSwiglu, SchedExpert, true>(lds, pg8::Gemm{D, D, D, gtab}, S, EpiSwiglu{p.HIDb_()});
}
__device__ __forceinline__ void phase_gemm_down(const Ptrs& p, const Ptrs& pn, int l, LAS unsigned char* lds, int G, int wg, bool xonly) {
    SchedExpert S; S.tpe = xonly ? BATCH * CAPX / 256 : ME / 256; S.init(NE * S.tpe, D / 256, G, wg); S.A = (const char*)p.HIDb_(); S.B = (const char*)p.Wt_d_(); S.sa = (size_t)256 * EH * 2; S.sb = (size_t)256 * EH * 2; S.sbz = (size_t)D * EH * 2;
    pg8::gemm_phase(lds, pg8::Gemm{EH, EH, EH, nullptr}, S, EpiStoreBf16{p.YSb_(), D});
    if (!xonly && wg >= 64) { const int tidq = opq((int)threadIdx.x), wv = tidq >> 6; cvt_weights_wave(pn, l + 1, (LAS float*)lds + wv * (64 * 65), 0, CF_DOWN, (wg - 64) * 8 + wv, (NWG - 64) * 8, tidq & 63); }
}

#define XB_TMO      128
#define XB_XCNT(j)  (256  + 64 * (j))
#define XB_XSUB(j)  (1280 + 64 * (j))
#define XB_XGEN(j)  (2304 + 64 * (j))
#define XB_TOP      3328
#define XB_TOPGEN   3392
#define XCD_BAR_WORDS 3456
#define XB_SPIN_CAP (1u << 18)
__device__ __forceinline__ unsigned xb_ld(unsigned* p)              { return __hip_atomic_load(p, __ATOMIC_RELAXED, __HIP_MEMORY_SCOPE_AGENT); }
__device__ __forceinline__ unsigned xb_add(unsigned* p, unsigned v) { return __hip_atomic_fetch_add(p, v, __ATOMIC_RELAXED, __HIP_MEMORY_SCOPE_AGENT); }
__device__ __forceinline__ unsigned xb_xcc_id() { return (unsigned)__builtin_amdgcn_s_getreg((3 << 11) | 20) & 0xFu; }
#define XB_SPIN(cond, bar) do { unsigned _sp = 0; while (cond) { __builtin_amdgcn_s_sleep(1); \
    if ((++_sp & 255u) == 0u) { if (xb_ld(&(bar)[XB_TMO])) break; if (_sp > XB_SPIN_CAP) { atomicAdd(&(bar)[XB_TMO], 1u); break; } } } } while (0)
struct XcdBarrier { unsigned* bar; unsigned x; volatile LAS unsigned* st; };
__device__ __forceinline__ XcdBarrier xcd_barrier_post(unsigned* bar, volatile LAS unsigned* st) {
    XcdBarrier b; b.bar = bar; b.x = xb_xcc_id(); b.st = st;
    if (threadIdx.x == 0) (void)xb_add(&bar[XB_XCNT(b.x)], 1u);
    return b;
}
__device__ __forceinline__ void xcd_barrier_complete(unsigned* bar, unsigned x, unsigned& nloc, unsigned& nx) {
    const unsigned G = NWG;
    unsigned sum, cnt, mine, sp = 0u;
    for (;;) {
        sum = 0u; cnt = 0u; mine = 0u;
#pragma unroll
        for (unsigned j = 0; j < 16; ++j) { const unsigned c = xb_ld(&bar[XB_XCNT(j)]); sum += c; cnt += (c > 0u) ? 1u : 0u; mine = (j == x) ? c : mine; }
        if (sum == G) break;
        __builtin_amdgcn_s_sleep(1);
        if ((++sp & 255u) == 0u) { if (xb_ld(&bar[XB_TMO])) break; if (sp > XB_SPIN_CAP) { atomicAdd(&bar[XB_TMO], 1u); break; } }
    }
    nloc = mine > 0u ? mine : 1u; nx = cnt > 0u ? cnt : 1u;
}
__device__ __forceinline__ void xcd_barrier(const XcdBarrier& b) {
    asm volatile("s_waitcnt vmcnt(0)" ::: "memory");
    __syncthreads();
    if (threadIdx.x == 0) {
        unsigned* bar = b.bar; unsigned bx = b.x;
        asm volatile("" : "+s"(bar), "+s"(bx));
        __builtin_amdgcn_s_waitcnt(0);
        unsigned nloc = b.st[0], nx = b.st[1];
        if (nloc == 0u) { xcd_barrier_complete(bar, bx, nloc, nx); b.st[0] = nloc; b.st[1] = nx; }
        const unsigned old = xb_add(&bar[XB_XSUB(bx)], 1u);
        const unsigned gen = old / nloc;
        if (old + 1u == (gen + 1u) * nloc) {
            __builtin_amdgcn_fence(__ATOMIC_RELEASE, "agent");
            asm volatile("s_waitcnt vmcnt(0)" ::: "memory");
            const unsigned og = xb_add(&bar[XB_TOP], 1u);
            const unsigned tg = og / nx;
            if (og + 1u == (tg + 1u) * nx) xb_add(&bar[XB_TOPGEN], 1u);
            else XB_SPIN(xb_ld(&bar[XB_TOPGEN]) == tg, bar);
            __builtin_amdgcn_fence(__ATOMIC_ACQUIRE, "agent");
            xb_add(&bar[XB_XGEN(bx)], 1u);
            asm volatile("s_waitcnt vmcnt(0)" ::: "memory");
        } else {
            XB_SPIN(xb_ld(&bar[XB_XGEN(bx)]) == gen, bar);
            __builtin_amdgcn_fence(__ATOMIC_ACQUIRE, "agent");
            asm volatile("s_waitcnt vmcnt(0)" ::: "memory");
        }
    }
    __syncthreads();
}

template <int M> __device__ __forceinline__ int shx_raw(int v, int lane) {
    if constexpr (M == 32) { const auto r = __builtin_amdgcn_permlane32_swap(v, v, false, false); return (lane & 32) ? (int)r[0] : (int)r[1]; }
    else if constexpr (M == 16) { const auto r = __builtin_amdgcn_permlane16_swap(v, v, false, false); return (lane & 16) ? (int)r[0] : (int)r[1]; }
    else if constexpr (M == 8) return __builtin_amdgcn_update_dpp(0, v, 0x128, 0xF, 0xF, true);
    else if constexpr (M == 2) return __builtin_amdgcn_update_dpp(0, v, 0x4E, 0xF, 0xF, true);
    else if constexpr (M == 1) return __builtin_amdgcn_update_dpp(0, v, 0xB1, 0xF, 0xF, true);
    else return __builtin_amdgcn_ds_swizzle(v, 0x1F | (M << 10));
}
#define shx(v, m, lane) __int_as_float(shx_raw<m>(__float_as_int(v), lane))
#define shxi(v, m, lane) shx_raw<m>(v, lane)
__device__ __forceinline__ float shup(float v, int o, int lane) { return __int_as_float(__builtin_amdgcn_ds_bpermute((lane >= o ? lane - o : lane) << 2, __float_as_int(v))); }
__device__ __forceinline__ int shupi(int v, int o, int lane) { return __builtin_amdgcn_ds_bpermute((lane >= o ? lane - o : lane) << 2, v); }
__device__ __forceinline__ float wave_sum(float v, int lane) {
    { const auto r = __builtin_amdgcn_permlane32_swap(__float_as_int(v), __float_as_int(v), false, false); v = __int_as_float(r[0]) + __int_as_float(r[1]); }
    { const auto r = __builtin_amdgcn_permlane16_swap(__float_as_int(v), __float_as_int(v), false, false); v = __int_as_float(r[0]) + __int_as_float(r[1]); }
    v += shx(v, 8, lane); v += shx(v, 4, lane); v += shx(v, 2, lane); v += shx(v, 1, lane); return v; }
template <int CTRL> __device__ __forceinline__ float dpp_mov(float x) { return __int_as_float(__builtin_amdgcn_update_dpp(0, __float_as_int(x), CTRL, 0xF, 0xF, true)); }
__device__ __forceinline__ void wave_sum16(const float (&a)[16], float (&S)[16], int lane) {
    float r1[8], r2[4], r3[2];
#pragma unroll
    for (int i = 0; i < 8; ++i) { const auto r = __builtin_amdgcn_permlane32_swap(__float_as_int(a[i]), __float_as_int(a[i + 8]), false, false); r1[i] = __int_as_float(r[0]) + __int_as_float(r[1]); }
#pragma unroll
    for (int i = 0; i < 4; ++i) { const auto r = __builtin_amdgcn_permlane16_swap(__float_as_int(r1[i]), __float_as_int(r1[i + 4]), false, false); r2[i] = __int_as_float(r[0]) + __int_as_float(r[1]); }
    const bool hi8 = lane & 8;
#pragma unroll
    for (int i = 0; i < 2; ++i) { const float keep = hi8 ? r2[i + 2] : r2[i], send = hi8 ? r2[i] : r2[i + 2]; float x = keep + dpp_mov<0x128>(send);
        x += dpp_mov<0x141>(x); x += dpp_mov<0xB1>(x); x += dpp_mov<0x4E>(x); r3[i] = x; }
#pragma unroll
    for (int j = 0; j < 16; ++j) S[j] = __int_as_float(__builtin_amdgcn_readlane(__float_as_int(r3[j & 1]), 8 * ((j >> 1) & 1) + 16 * ((j >> 2) & 1) + 32 * (j >> 3)));
}
__device__ __forceinline__ void phase_adaln(const Ptrs& p, LAS float* sl, int G, int wg) {
    LAS float* red = sl + NCOND * D;
    const int tid = opq((int)threadIdx.x), col = tid & 127, kg = tid >> 7;
    for (int i = tid; i < NCOND * D; i += NTHREADS) { const int ci = i / D, k = i % D; sl[i] = siluf_(ci < BATCH ? p.c[ci * D + k] : p.c_ctx[k]); }
    __syncthreads();
#pragma unroll 1
    for (int tile = wg; tile < DEPTH * 6 * D / 128; tile += G) { const int l = tile / (6 * D / 128), j = (tile % (6 * D / 128)) * 128 + col;
        float acc[NCOND];
#pragma unroll
        for (int ci = 0; ci < NCOND; ++ci) acc[ci] = 0.f;
        const float* wp = p.w_ada + ((size_t)l * D + kg * 256) * 6 * D + j;
#pragma unroll 4
        for (int k = 0; k < 256; ++k) { const float w = wp[(size_t)k * 6 * D];
#pragma unroll
            for (int ci = 0; ci < NCOND; ++ci) acc[ci] += sl[ci * D + kg * 256 + k] * w; }
#pragma unroll
        for (int ci = 0; ci < NCOND; ++ci) red[(kg * NCOND + ci) * 128 + col] = acc[ci];
        __syncthreads();
        if (kg == 0) { const float ba = p.b_ada[(size_t)l * 6 * D + j];
#pragma unroll
            for (int ci = 0; ci < NCOND; ++ci) p.MOD_()[((size_t)l * NCOND + ci) * 6 * D + j] = red[ci * 128 + col] + red[(NCOND + ci) * 128 + col] + red[(2 * NCOND + ci) * 128 + col] + red[(3 * NCOND + ci) * 128 + col] + ba; }
        __syncthreads();
    }
}
enum { MODE_N1 = 0, MODE_N2 = 1, MODE_FINAL = 2 };
template <int MODE, bool XONLY = false> __device__ __forceinline__ void phase_rows(const Ptrs& p, int l, LAS float* wl, int G, int wg) {
    const int tid = opq((int)threadIdx.x), lane = tid & 63, wave = tid >> 6;
    constexpr int NROWS = (MODE == MODE_FINAL || XONLY) ? BX : NR, PER = NROWS / (NWG * 8);
    static_assert(NROWS % (NWG * 8) == 0, "rows per wave");
    constexpr bool MIXED = NROWS == NR; static_assert(!MIXED || (PER == 9 && BX == NWG * 8 * 8 && BC == NWG * 8), "row split");
    const int wv_ = wg * 8 + wave, r0 = MIXED ? wv_ * 8 : wv_ * PER;
#define ROW_OF(k) ((MIXED && (k) == PER - 1) ? BX + wv_ : r0 + (k))
    const float* xsrc = (MODE == MODE_N1 && l == 0) ? nullptr : p.X_();
    f32x4 gn[4], sh[4], sc[4], g2[4];
    if constexpr (MODE != MODE_FINAL) {
#pragma unroll
        for (int j = 0; j < 4; ++j) gn[j] = *(const f32x4*)((MODE == MODE_N2 ? p.norm2_g : p.norm1_g) + (size_t)l * D + 4 * lane + 256 * j); }
    int ci_cur = -1;
    f32x4 xn[4];
#define ROWS_LOAD(dst, r) do { const float* _s = xsrc ? xsrc + (size_t)(r) * D : ((r) < BX ? p.x + (size_t)(r) * D : p.ctx + (size_t)((r) - BX) * D); \
        _Pragma("unroll") for (int j = 0; j < 4; ++j) dst[j] = *(const f32x4*)(_s + 4 * lane + 256 * j); } while (0)
    f32x4 xn2[4];
    ROWS_LOAD(xn, r0); if (PER > 1) ROWS_LOAD(xn2, ROW_OF(1));
    if constexpr (MODE == MODE_N2) {
        const float* wr = p.w_router + (size_t)l * D * NE;
        { float wv[D * NE / NTHREADS];
#pragma unroll
          for (int k = 0; k < D * NE / NTHREADS; ++k) wv[k] = wr[(size_t)(tid + (k >> 4) * NTHREADS) * NE + (k & 15)];
          __builtin_amdgcn_sched_barrier(0);
#pragma unroll
          for (int k = 0; k < D * NE / NTHREADS; ++k) wl[(k & 15) * D + tid + (k >> 4) * NTHREADS] = wv[k]; }
        __syncthreads();
    }
    constexpr bool COMBINE = MODE == MODE_FINAL || MODE == MODE_N1;
    int rk_n = 1 << 30; float af_n = 0.f;
    if (COMBINE && (MODE == MODE_FINAL || l > 0) && lane < NE) { rk_n = p.RANK_()[(size_t)r0 * NE + lane]; af_n = p.AFF_()[(size_t)r0 * NE + lane]; }
#pragma unroll 1
    for (int k = 0; k < PER; ++k) { const int r = ROW_OF(k), rnx = ROW_OF(k + 1);
        const bool isx = r < BX; const int b = isx ? r / SEQ : (r - BX) / CTX; const int ci = isx ? b : BATCH;
        f32x4 x[4];
#pragma unroll
        for (int j = 0; j < 4; ++j) x[j] = xn[j];
#pragma unroll
        for (int j = 0; j < 4; ++j) xn[j] = xn2[j];
        if (k + 2 < PER) ROWS_LOAD(xn2, ROW_OF(k + 2));
        if (ci != ci_cur) { ci_cur = ci;
            if constexpr (MODE != MODE_FINAL) { const float* md = p.MOD_() + ((size_t)l * NCOND + ci) * 6 * D + (MODE == MODE_N2 ? 3 * D : 0) + 4 * lane;
#pragma unroll
                for (int j = 0; j < 4; ++j) { sh[j] = *(const f32x4*)(md + 256 * j); sc[j] = 1.0f + *(const f32x4*)(md + D + 256 * j); } }
            if ((MODE == MODE_N1 && l > 0) || MODE == MODE_FINAL) { const int lm = MODE == MODE_FINAL ? DEPTH - 1 : l - 1;
                const float* gp = p.MOD_() + ((size_t)lm * NCOND + ci) * 6 * D + 5 * D + 4 * lane;
#pragma unroll
                for (int j = 0; j < 4; ++j) g2[j] = *(const f32x4*)(gp + 256 * j); } }
        if ((MODE == MODE_N1 && l > 0) || MODE == MODE_FINAL) {
            const int cap = isx ? CAPX : CAPC;
            const int rk = rk_n; const float af = af_n;
            if (k + 1 < PER && lane < NE) { rk_n = p.RANK_()[(size_t)rnx * NE + lane]; af_n = p.AFF_()[(size_t)rnx * NE + lane]; }
            unsigned long long m = __ballot(rk < cap);
            f32x4 acc[4];
#pragma unroll
            for (int j = 0; j < 4; ++j) { const float z = zero_f(); acc[j] = (f32x4){z, z, z, z}; }
            while (m) { const int e = __builtin_ctzll(m); m &= m - 1; const bool two = m != 0; const int e2 = two ? __builtin_ctzll(m) : e; m &= m - 1;
                const int rke = __builtin_amdgcn_readlane(rk, e), rke2 = __builtin_amdgcn_readlane(rk, e2);
                const float afe = __int_as_float(__builtin_amdgcn_readlane(__float_as_int(af), e)), afe2 = two ? __int_as_float(__builtin_amdgcn_readlane(__float_as_int(af), e2)) : 0.f;
                const int sb = isx ? b * CAPX : BATCH * CAPX + b * CAPC;
                const bf16_t* ys = p.YSb_() + ((size_t)e * ME + sb + rke) * D + 4 * lane; const bf16_t* ys2 = p.YSb_() + ((size_t)e2 * ME + sb + rke2) * D + 4 * lane;
                u32x2 y1[4], y2[4];
#pragma unroll
                for (int j = 0; j < 4; ++j) { y1[j] = *(const u32x2*)(ys + 256 * j); y2[j] = *(const u32x2*)(ys2 + 256 * j); }
#pragma unroll
                for (int j = 0; j < 4; ++j) acc[j] += afe * bf4(y1[j]) + afe2 * bf4(y2[j]); }
#pragma unroll
            for (int j = 0; j < 4; ++j) x[j] += g2[j] * acc[j];
        }
        if constexpr (MODE == MODE_N2 && !XONLY) { if (!isx) {
            const float* g1 = p.MOD_() + ((size_t)l * NCOND + ci) * 6 * D + 2 * D + 4 * lane; const bf16_t* op = (const bf16_t*)p.OP_() + (size_t)(r - BX) * D + 4 * lane;
            u32x2 pv[4][6]; f32x4 g1v[4];
#pragma unroll
            for (int j = 0; j < 4; ++j) { g1v[j] = *(const f32x4*)(g1 + 256 * j);
#pragma unroll
                for (int q = 0; q < 6; ++q) pv[j][q] = *(const u32x2*)(op + (size_t)q * BC * D + 256 * j); }
            __builtin_amdgcn_sched_barrier(0);
#pragma unroll
            for (int j = 0; j < 4; ++j) { x[j] += g1v[j] * ((bf4(pv[j][0]) + bf4(pv[j][1]) + bf4(pv[j][2])) + (bf4(pv[j][3]) + bf4(pv[j][4]) + bf4(pv[j][5])));
                *(f32x4*)(p.X_() + (size_t)r * D + 4 * lane + 256 * j) = x[j]; } } }
        if constexpr (MODE == MODE_FINAL) {
#pragma unroll
            for (int j = 0; j < 4; ++j) *(f32x4*)(p.out + (size_t)r * D + 4 * lane + 256 * j) = x[j];
        } else {
            if constexpr (MODE == MODE_N1) {
#pragma unroll
                for (int j = 0; j < 4; ++j) *(f32x4*)(p.X_() + (size_t)r * D + 4 * lane + 256 * j) = x[j]; }
            float ss = 0.f;
#pragma unroll
            for (int j = 0; j < 4; ++j) ss += x[j][0] * x[j][0] + x[j][1] * x[j][1] + x[j][2] * x[j][2] + x[j][3] * x[j][3];
            const float rs = rsqrtf(wave_sum(ss, lane) * (1.0f / D) + EPS);
            f32x4 h[4];
#pragma unroll
            for (int j = 0; j < 4; ++j) { h[j] = x[j] * rs * gn[j] * sc[j] + sh[j];
                u32x2 w; w.x = cvt_pk_bf16(h[j][0], h[j][1]); w.y = cvt_pk_bf16(h[j][2], h[j][3]); *(u32x2*)(p.HXb_() + (size_t)r * D + 4 * lane + 256 * j) = w; }
            if constexpr (MODE == MODE_N2) {
                float v16[NE];
#pragma unroll
                for (int eg = 0; eg < NE; eg += 4) { f32x4 w[4][4];
#pragma unroll
                    for (int q = 0; q < 4; ++q)
#pragma unroll
                        for (int j = 0; j < 4; ++j) w[q][j] = *(const LAS f32x4*)(wl + (eg + q) * D + 4 * lane + 256 * j);
                    __builtin_amdgcn_sched_barrier(0);
#pragma unroll
                    for (int q = 0; q < 4; ++q) { float s = 0.f;
#pragma unroll
                        for (int j = 0; j < 4; ++j) s += h[j][0] * w[q][j][0] + h[j][1] * w[q][j][1] + h[j][2] * w[q][j][2] + h[j][3] * w[q][j][3];
                        v16[eg + q] = s; } }
                float v8[8], v4[4], v2[2], v1;
#pragma unroll
                for (int i = 0; i < 8; ++i) { const auto r = __builtin_amdgcn_permlane32_swap(__float_as_int(v16[i]), __float_as_int(v16[i + 8]), false, false); v8[i] = __int_as_float(r[0]) + __int_as_float(r[1]); }
#pragma unroll
                for (int i = 0; i < 4; ++i) { const auto r = __builtin_amdgcn_permlane16_swap(__float_as_int(v8[i]), __float_as_int(v8[i + 4]), false, false); v4[i] = __int_as_float(r[0]) + __int_as_float(r[1]); }
                { const bool hi = lane & 8;
#pragma unroll
                  for (int i = 0; i < 2; ++i) { const float snd = hi ? v4[i] : v4[i + 2]; v2[i] = (hi ? v4[i + 2] : v4[i]) + shx(snd, 8, lane); } }
                { const bool hi = lane & 4; const float snd = hi ? v2[0] : v2[1]; v1 = (hi ? v2[1] : v2[0]) + shx(snd, 4, lane); }
                v1 += shx(v1, 2, lane); v1 += shx(v1, 1, lane);
                float mx = v1; mx = fmaxf(mx, shx(mx, 4, lane)); mx = fmaxf(mx, shx(mx, 8, lane)); mx = fmaxf(mx, shx(mx, 16, lane)); mx = fmaxf(mx, shx(mx, 32, lane));
                const float ex = fexp(v1 - mx); float den = ex; den += shx(den, 4, lane); den += shx(den, 8, lane); den += shx(den, 16, lane); den += shx(den, 32, lane);
                const int e = ((lane >> 5) & 1) * 8 + ((lane >> 4) & 1) * 4 + ((lane >> 3) & 1) * 2 + ((lane >> 2) & 1);
                if ((lane & 3) == 0) p.AFF_()[(size_t)r * NE + e] = ex / den;
            }
        }
    }
#undef ROWS_LOAD
#undef ROW_OF
}
__device__ __forceinline__ int wave_isum(int v, int lane) { v += shxi(v, 32, lane); v += shxi(v, 16, lane); v += shxi(v, 8, lane); v += shxi(v, 4, lane); v += shxi(v, 2, lane); v += shxi(v, 1, lane); return v; }
__device__ __forceinline__ int block_excl_scan(int local, LAS unsigned* wsum, int lane, int wave) {
    int inc = local;
#pragma unroll
    for (int o = 1; o < 64; o <<= 1) { const int t = shupi(inc, o, lane); if (lane >= o) inc += t; }
    if (lane == 63) wsum[wave] = (unsigned)inc;
    __syncthreads();
    int off = 0;
#pragma unroll
    for (int w = 0; w < NTHREADS / 64; ++w) off += w < wave ? (int)wsum[w] : 0;
    __syncthreads();
    return off + inc - local;
}
__device__ __forceinline__ void phase_rank(const Ptrs& p, LAS unsigned* sh, int G, int wg, bool xonly) {
    const int tid = opq((int)threadIdx.x), lane = tid & 63, wave = tid >> 6;
#pragma unroll 1
    for (int u = wg; u < (xonly ? 1 : 2) * BATCH * NE; u += G) {
        const bool isx = u < BATCH * NE; const int v = isx ? u : u - BATCH * NE, b = v / NE, e = v % NE, T = isx ? SEQ : CTX, base = isx ? b * SEQ : BX + b * CTX, cap = isx ? CAPX : CAPC;
        unsigned key[4]; bool valid[4];
#pragma unroll
        for (int k = 0; k < 4; ++k) { const int t = 4 * tid + k; valid[k] = t < T; key[k] = valid[k] ? __float_as_uint(p.AFF_()[(size_t)(base + t) * NE + e]) : 0u; }
        if (tid < 64) sh[tid] = 0u;
        __syncthreads();
        unsigned thr = 0u;
#define RANK_CNT(cnd) (__builtin_popcountll(__ballot(key[0] >= (cnd))) + __builtin_popcountll(__ballot(key[1] >= (cnd))) + __builtin_popcountll(__ballot(key[2] >= (cnd))) + __builtin_popcountll(__ballot(key[3] >= (cnd))))
#pragma unroll 1
        for (int st = 0; st < 16; ++st) { const unsigned bhi = st < 15 ? 1u << (30 - 2 * st) : 1u, blo = st < 15 ? 1u << (29 - 2 * st) : 0u;
            const unsigned c1 = thr | blo, c2 = thr | bhi, c3 = c2 | blo;
            const int n1 = RANK_CNT(c1), n2 = RANK_CNT(c2), n3 = RANK_CNT(c3);
            if (lane == 0) { if (n1) __hip_atomic_fetch_add(&sh[3 * st], (unsigned)n1, __ATOMIC_RELAXED, __HIP_MEMORY_SCOPE_WORKGROUP); if (n2) __hip_atomic_fetch_add(&sh[3 * st + 1], (unsigned)n2, __ATOMIC_RELAXED, __HIP_MEMORY_SCOPE_WORKGROUP);
                             if (n3) __hip_atomic_fetch_add(&sh[3 * st + 2], (unsigned)n3, __ATOMIC_RELAXED, __HIP_MEMORY_SCOPE_WORKGROUP); }
            __syncthreads();
            const int t1 = (int)sh[3 * st], t2 = (int)sh[3 * st + 1], t3 = (int)sh[3 * st + 2];
            thr = t2 >= cap ? (t3 >= cap ? c3 : c2) : (t1 >= cap ? c1 : thr); }
#undef RANK_CNT
        { const int c = __builtin_popcountll(__ballot(key[0] > thr)) + __builtin_popcountll(__ballot(key[1] > thr)) + __builtin_popcountll(__ballot(key[2] > thr)) + __builtin_popcountll(__ballot(key[3] > thr)); if (lane == 0 && c) __hip_atomic_fetch_add(&sh[63], (unsigned)c, __ATOMIC_RELAXED, __HIP_MEMORY_SCOPE_WORKGROUP); }
        __syncthreads();
        const int need_eq = cap - (int)sh[63];
        int feq[4], sel[4], loc = 0;
#pragma unroll
        for (int k = 0; k < 4; ++k) { feq[k] = valid[k] && key[k] == thr; loc += feq[k]; }
        int pre = block_excl_scan(loc, sh + 32, lane, wave); loc = 0;
#pragma unroll
        for (int k = 0; k < 4; ++k) { sel[k] = valid[k] && (key[k] > thr || (feq[k] && pre < need_eq)); pre += feq[k]; loc += sel[k]; }
        int slot = block_excl_scan(loc, sh + 40, lane, wave);
        const int slot0 = isx ? b * CAPX : BATCH * CAPX + b * CAPC;
#pragma unroll
        for (int k = 0; k < 4; ++k) { const int t = 4 * tid + k; if (valid[k]) { p.RANK_()[(size_t)(base + t) * NE + e] = sel[k] ? slot : (1 << 30); if (sel[k]) p.IDX_()[e * ME + slot0 + slot] = base + t; slot += sel[k]; } }
        __syncthreads();
    }
}

typedef float f32x16 __attribute__((ext_vector_type(16)));
typedef float f32x2 __attribute__((ext_vector_type(2)));
typedef __bf16 bf16x2v __attribute__((ext_vector_type(2)));
using pg8::bf16x8;
__device__ __forceinline__ unsigned pk2(float a, float b) { const f32x2 v = {a, b}; return __builtin_bit_cast(unsigned, __builtin_convertvector(v, bf16x2v)); }
__device__ __forceinline__ bf16x8 pack8(const f32x16& x, int s) { u32x4 q; q[0] = pk2(x[8 * s], x[8 * s + 1]); q[1] = pk2(x[8 * s + 2], x[8 * s + 3]); q[2] = pk2(x[8 * s + 4], x[8 * s + 5]); q[3] = pk2(x[8 * s + 6], x[8 * s + 7]); return __builtin_bit_cast(bf16x8, q); }
#define MFMA32(a, b, c) __builtin_amdgcn_mfma_f32_32x32x16_bf16((a), (b), (c), 0, 0, 0)
__device__ __forceinline__ int crow(int reg, int hh) { return (reg & 3) + 8 * (reg >> 2) + 4 * hh; }
constexpr int NCHUNK = (BX + BC) / 64, NXCH = BX / 64, NPROB = NCHUNK * GH * 2;
constexpr int GFRAGS = 56;
__device__ __forceinline__ void chunk_rows(int chunk, int& base, int& sbase, int& slen) {
    if (chunk < NXCH) { const int b = chunk / (SEQ / 64), c = chunk % (SEQ / 64); sbase = b * SEQ; slen = SEQ; base = sbase + c * 64; }
    else { const int q = chunk - NXCH, b = q / (CTX / 64), c = q % (CTX / 64); sbase = BX + b * CTX; slen = CTX; base = sbase + c * 64; }
}
constexpr int KST = 136;
constexpr int QST = 68;
constexpr int OFF_KB = 0, OFF_QB = 64 * KST * 2, OFF_VF = 2 * 64 * KST * 2, OFF_KK = OFF_VF + 64 * 128 * 4, OFF_QK = OFF_KK + 64 * 64 * 4, OFF_AT = OFF_QK + 64 * QST * 4, OFF_GC = LDS_BAR_OFF - 2048  ,
              OFF_WS = OFF_VF  ;
constexpr int IST = 72;
constexpr int OFF_TB = OFF_AT + 2 * 64 * 64 * 4  ;
static_assert(OFF_GC + 2048 <= LDS_BAR_OFF && OFF_TB + 2 * 64 * IST * 2 <= OFF_GC && OFF_WS + 2 * 64 * KST * 2 <= OFF_QK, "gdn_local LDS map");

template <int J, int IB> __device__ __forceinline__ void gdn_solve32_load(f32x4& q, const LAS float* ab) {
    constexpr int first = J + 1 - 4 * IB; const LAS float* src = ab + J * 64 + 4 * IB;
    if constexpr (first <= 0) q = *(const LAS f32x4*)src;
    else { if constexpr (first == 1) q[1] = src[1];
           if constexpr (first <= 2) { const f32x2 t = *(const LAS f32x2*)(src + 2); q[2] = t[0]; q[3] = t[1]; }
           else q[3] = src[3]; }
}
template <int J, int IB> __device__ __forceinline__ void gdn_solve32_block(float (&R)[32], const LAS float*& ab, f32x4 (&q)[8], float xj) {
    if constexpr (4 * IB + 3 > J) {
#pragma unroll
        for (int e = 0; e < 4; ++e) if (4 * IB + e > J) R[4 * IB + e] -= q[IB][e] * xj;
        if constexpr (J + 1 < 31 && 4 * IB + 3 > J + 1) {
            asm volatile("" : "+v"(R[4 * IB]), "+v"(R[4 * IB + 1]), "+v"(R[4 * IB + 2]), "+v"(R[4 * IB + 3]), "+v"(ab));
            gdn_solve32_load<J + 1, IB>(q[IB], ab); } }
}
template <int J> __device__ __forceinline__ void gdn_solve32_step(float (&R)[32], const LAS float*& ab, f32x4 (&q)[8]) {
    const float xj = R[J];
    gdn_solve32_block<J, 0>(R, ab, q, xj); gdn_solve32_block<J, 1>(R, ab, q, xj); gdn_solve32_block<J, 2>(R, ab, q, xj); gdn_solve32_block<J, 3>(R, ab, q, xj);
    gdn_solve32_block<J, 4>(R, ab, q, xj); gdn_solve32_block<J, 5>(R, ab, q, xj); gdn_solve32_block<J, 6>(R, ab, q, xj); gdn_solve32_block<J, 7>(R, ab, q, xj);
}
template <int... Js> __device__ __forceinline__ void gdn_solve32_all(float (&R)[32], const LAS float* ab, std::integer_sequence<int, Js...>) {
    f32x4 q[8];
    gdn_solve32_load<0, 0>(q[0], ab); gdn_solve32_load<0, 1>(q[1], ab); gdn_solve32_load<0, 2>(q[2], ab); gdn_solve32_load<0, 3>(q[3], ab);
    gdn_solve32_load<0, 4>(q[4], ab); gdn_solve32_load<0, 5>(q[5], ab); gdn_solve32_load<0, 6>(q[6], ab); gdn_solve32_load<0, 7>(q[7], ab);
    (gdn_solve32_step<Js>(R, ab, q), ...);
}
__device__ __forceinline__ void phase_gdn_local(const Ptrs& p, int l, LAS unsigned char* lds, int G, int wg) {
    const int tid0 = opq((int)threadIdx.x);
    LAS bf16_t* Kb = (LAS bf16_t*)(lds + OFF_KB); LAS bf16_t* Qb = (LAS bf16_t*)(lds + OFF_QB); LAS float* VF = (LAS float*)(lds + OFF_VF); LAS float* KK = (LAS float*)(lds + OFF_KK);
    LAS float* QK = (LAS float*)(lds + OFF_QK); LAS float* AT = (LAS float*)(lds + OFF_AT); LAS float* GC = (LAS float*)(lds + OFF_GC); LAS float* BL = GC + 128; LAS float* GE = GC + 384  ; LAS bf16_t* Tb = (LAS bf16_t*)(lds + OFF_TB); LAS bf16_t* Ws = (LAS bf16_t*)(lds + OFF_WS);
#pragma unroll 1
    for (int u = wg; u < NCHUNK * GH; u += G) {
        const int tid = opq(tid0), lane = tid & 63, wave = tid >> 6;
        const int chunk = u / GH, h = u % GH; int base, sbase, slen; chunk_rows(chunk, base, sbase, slen);
        const int tidu = opq(tid), gd = tidu >> 6, gtk = (gd & 1) ? 63 - (tidu & 63) : (tidu & 63); bf16_t ga_raw = 0, gb_raw = 0; float galog = 0.f, gdtb = 0.f;
        if (tidu < 128) { const size_t r = (size_t)(base + gtk); ga_raw = p.Pb_()[r * LDP + C_A + gd * GH + h]; gb_raw = p.Pb_()[r * LDP + C_B + gd * GH + h]; galog = p.gdn_a_log[(l * 2 + gd) * GH + h]; gdtb = p.gdn_dt_bias[(l * 2 + gd) * GH + h]; }
        {
            float cw[4][6];
#pragma unroll
            for (int j = 0; j < 4; ++j)
#pragma unroll
                for (int q = 0; q < 3; ++q) { const f32x2 w2 = *(const f32x2*)(p.gdn_conv_w + ((size_t)l * 4 + j) * 3 * BW + q * BW + h * GDK + 2 * lane); cw[j][2 * q] = w2[0]; cw[j][2 * q + 1] = w2[1]; }
            float rows[11][6]; unsigned raw[11][3];
#pragma unroll
            for (int rr = 0; rr < 11; ++rr) { const int r = base + wave * 8 + rr - 2; const int rc = min(max(r, sbase), sbase + slen - 1);
#pragma unroll
                for (int q = 0; q < 3; ++q) raw[rr][q] = *(const unsigned*)(p.Pb_() + (size_t)rc * LDP + q * BW + h * GDK + 2 * lane); }
            __builtin_amdgcn_sched_barrier(0);
#pragma unroll
            for (int rr = 0; rr < 11; ++rr) { const int r = base + wave * 8 + rr - 2; const bool ok = r >= sbase && r < sbase + slen;
#pragma unroll
                for (int q = 0; q < 3; ++q) { const unsigned w2 = ok ? raw[rr][q] : 0u; rows[rr][2 * q] = __uint_as_float(w2 << 16); rows[rr][2 * q + 1] = __uint_as_float(w2 & 0xffff0000u); } }
            float qk[8][4], ssq[16], S[16];
#pragma unroll
            for (int tt = 0; tt < 8; ++tt) { float v[6];
#pragma unroll
                for (int c = 0; c < 6; ++c) v[c] = siluf_(cw[0][c] * rows[tt][c] + cw[1][c] * rows[tt + 1][c] + cw[2][c] * rows[tt + 2][c] + cw[3][c] * rows[tt + 3][c]);
                qk[tt][0] = v[0]; qk[tt][1] = v[1]; qk[tt][2] = v[2]; qk[tt][3] = v[3]; ssq[2 * tt] = v[0] * v[0] + v[1] * v[1]; ssq[2 * tt + 1] = v[2] * v[2] + v[3] * v[3];
                *(LAS f32x2*)(VF + (wave * 8 + tt) * 128 + 2 * lane) = (f32x2){v[4], v[5]}; }
            wave_sum16(ssq, S, lane);
#pragma unroll
            for (int tt = 0; tt < 8; ++tt) { const float qs = __builtin_amdgcn_rsqf(S[2 * tt] + EPS) * 0.08838834764831845f, ks = __builtin_amdgcn_rsqf(S[2 * tt + 1] + EPS); const int t = wave * 8 + tt;
                *(LAS unsigned*)(Qb + t * KST + 2 * lane) = pk2(qk[tt][0] * qs, qk[tt][1] * qs); *(LAS unsigned*)(Kb + t * KST + 2 * lane) = pk2(qk[tt][2] * ks, qk[tt][3] * ks); }
        }
        unsigned touch = 0;
        { const int un = u + G; if (un < NCHUNK * GH && tid < 67 * 6) { int bn, sbn, sln; chunk_rows(un / GH, bn, sbn, sln); const int rr = tid / 6, pc = tid % 6, rc = min(max(bn - 2 + rr, sbn), sbn + sln - 1);
            touch = *(const unsigned*)(p.Pb_() + (size_t)rc * LDP + (pc >> 1) * BW + (un % GH) * GDK + (pc & 1) * 64); } }
        if (tid < 128) { const int d = gd; const float a = bf2f(ga_raw), bb = bf2f(gb_raw);
            float gcv = -expf(galog) * softplusf_(a + gdtb);
            const int lu = tidu & 63;
#pragma unroll
            for (int o = 1; o < 64; o <<= 1) { const float t2 = shup(gcv, o, lu); if (lu >= o) gcv += t2; }
            const float glast = __int_as_float(__builtin_amdgcn_readlane(__float_as_int(gcv), 63));
            GC[d * 64 + lu] = gcv; GE[d * 64 + lu] = fexp(gcv); BL[d * 64 + lu] = sigmoidf_(bb); GC[256 + d * 64 + lu] = fexp(glast - gcv); }
        __syncthreads();
        { const int which = wave >> 2, tm = (wave >> 1) & 1, tn = wave & 1, m = lane & 31, hh = lane >> 5; const LAS bf16_t* Xb = which ? Qb : Kb;
            f32x16 acc;
            { const float z = zero_f();
#pragma unroll
            for (int v = 0; v < 16; ++v) acc[v] = z; }
            { bf16x8 xa[8], xb[8];
#pragma unroll
              for (int ks = 0; ks < 8; ++ks) { xa[ks] = *(const LAS bf16x8*)(Xb + (32 * tm + m) * KST + 16 * ks + 8 * hh); xb[ks] = *(const LAS bf16x8*)(Kb + (32 * tn + m) * KST + 16 * ks + 8 * hh); }
              __builtin_amdgcn_sched_barrier(0);
#pragma unroll
              for (int ks = 0; ks < 8; ++ks) acc = MFMA32(xa[ks], xb[ks], acc); }
            LAS float* O = which ? QK : KK; const int ost = which ? QST : 64;
#pragma unroll
            for (int v = 0; v < 16; ++v) O[(32 * tm + crow(v, hh)) * ost + 32 * tn + m] = acc[v]; }
        __syncthreads();
#pragma unroll
        for (int d = 0; d < 2; ++d) { const int dm = d ? 63 : 0, ti = lane ^ dm; const float bl = BL[d * 64 + lane], gi = GC[d * 64 + lane]; float kk[8], gj[8];
#pragma unroll
            for (int m = 0; m < 8; ++m) { const int j = wave + 8 * m; kk[m] = KK[(j ^ dm) * 64 + ti]; gj[m] = GC[d * 64 + j]; }
            __builtin_amdgcn_sched_barrier(0);
#pragma unroll
            for (int m = 0; m < 8; ++m) { const int j = wave + 8 * m; AT[d * 4096 + j * 64 + lane] = lane > j ? bl * kk[m] * fexp(gi - gj[m]) : 0.f; } }
        __syncthreads();
        const int tqq = opq(tid), lqq = tqq & 63, hhq = lqq >> 5, nq = lqq & 31, wvq = __builtin_amdgcn_readfirstlane(tqq >> 6);
        bf16x8 bfr[3][4];
        if (wvq < 2) { float R[32]; const int lq = lqq, hf = lq >> 5, c = lq & 31;
#pragma unroll
            for (int i = 0; i < 32; ++i) R[i] = i == c ? 1.0f : 0.0f;
            gdn_solve32_all(R, AT + wvq * 4096 + hf * (32 * 64 + 32), std::make_integer_sequence<int, 31>{});
            LAS bf16_t* tb = Tb + wvq * 64 * IST;
#pragma unroll
            for (int i = 0; i < 32; ++i) tb[(32 * hf + i) * IST + lq] = f2bf(R[i]);
            bf16x8 af[2], bfm[2];
#pragma unroll
            for (int ks = 0; ks < 2; ++ks) { float av[8], bv[8];
#pragma unroll
                for (int jj = 0; jj < 8; ++jj) { av[jj] = AT[wvq * 4096 + (16 * ks + 8 * hf + jj) * 64 + 32 + c]; const float sw = shx(R[16 * ks + 8 + jj], 32, lq); bv[jj] = hf ? sw : R[16 * ks + jj]; }
                af[ks] = __builtin_bit_cast(bf16x8, (u32x4){pk2(av[0], av[1]), pk2(av[2], av[3]), pk2(av[4], av[5]), pk2(av[6], av[7])});
                bfm[ks] = __builtin_bit_cast(bf16x8, (u32x4){pk2(bv[0], bv[1]), pk2(bv[2], bv[3]), pk2(bv[4], bv[5]), pk2(bv[6], bv[7])}); }
            f32x16 Mx, T2; { const float z = zero_f();
#pragma unroll
            for (int v = 0; v < 16; ++v) { Mx[v] = z; T2[v] = z; } }
            Mx = MFMA32(af[0], bfm[0], Mx); Mx = MFMA32(af[1], bfm[1], Mx);
#pragma unroll
            for (int ks = 0; ks < 2; ++ks) { const LAS bf16_t* src = tb + (32 + c) * IST + 32 + 16 * ks + 4 * hf;
                const u32x2 lo = *(const LAS u32x2*)src, hi = *(const LAS u32x2*)(src + 8);
                T2 = MFMA32(__builtin_bit_cast(bf16x8, (u32x4){lo.x, lo.y, hi.x, hi.y}), pack8(Mx, ks), T2); }
#pragma unroll
            for (int v = 0; v < 16; ++v) tb[(32 + crow(v, hf)) * IST + c] = f2bf(-T2[v]); }
        else {
#pragma unroll
            for (int q = 0; q < 3; ++q) { const int T = wvq - 2 + 6 * q; if (T < 16) { const int dt = T >> 3, nt = T & 7, dmt = dt ? 63 : 0, col = 32 * nt + nq;
                if (nt >= 4) {
#pragma unroll
                    for (int ks = 0; ks < 4; ++ks) { float kv[8], sc[8];
#pragma unroll
                        for (int jj = 0; jj < 8; ++jj) { const int j = 16 * ks + 8 * hhq + jj; kv[jj] = bf2f(Kb[(j ^ dmt) * KST + col - 128]); sc[jj] = GE[dt * 64 + j] * BL[dt * 64 + j]; }
                        bfr[q][ks] = __builtin_bit_cast(bf16x8, (u32x4){pk2(kv[0] * sc[0], kv[1] * sc[1]), pk2(kv[2] * sc[2], kv[3] * sc[3]), pk2(kv[4] * sc[4], kv[5] * sc[5]), pk2(kv[6] * sc[6], kv[7] * sc[7])}); } }
                else {
#pragma unroll
                    for (int ks = 0; ks < 4; ++ks) { float vv[8], sc[8];
#pragma unroll
                        for (int jj = 0; jj < 8; ++jj) { const int j = 16 * ks + 8 * hhq + jj; vv[jj] = VF[(j ^ dmt) * 128 + col]; sc[jj] = BL[dt * 64 + j]; }
                        bfr[q][ks] = __builtin_bit_cast(bf16x8, (u32x4){pk2(vv[0] * sc[0], vv[1] * sc[1]), pk2(vv[2] * sc[2], vv[3] * sc[3]), pk2(vv[4] * sc[4], vv[5] * sc[5]), pk2(vv[6] * sc[6], vv[7] * sc[7])}); } } } }

            const LAS float* E2 = GC + 256;
#pragma unroll 1
            for (int ft = wvq - 2; ft < 64; ft += 6) { const int d2 = (ft >> 4) & 1, fl = ft & 15, dm2 = d2 ? 63 : 0; u32x4 o4; int f;
                if (ft < 32) { f = 16 + fl; const int i = 32 * (fl >> 3) + nq; const LAS bf16_t* src = Qb + (i ^ dm2) * KST + 16 * (fl & 7) + 4 * hhq; const float sc = GE[d2 * 64 + i];
                    const u32x2 lo = *(const LAS u32x2*)src, hi = *(const LAS u32x2*)(src + 8);
                    o4 = (u32x4){pk2(__uint_as_float(lo.x << 16) * sc, __uint_as_float(lo.x & 0xffff0000u) * sc), pk2(__uint_as_float(lo.y << 16) * sc, __uint_as_float(lo.y & 0xffff0000u) * sc),
                                 pk2(__uint_as_float(hi.x << 16) * sc, __uint_as_float(hi.x & 0xffff0000u) * sc), pk2(__uint_as_float(hi.y << 16) * sc, __uint_as_float(hi.y & 0xffff0000u) * sc)}; }
                else { f = 40 + fl; const int dk = 32 * (fl >> 2) + nq, c0 = 16 * (fl & 3) + 4 * hhq; const f32x4 ea = *(const LAS f32x4*)(E2 + d2 * 64 + c0), eb = *(const LAS f32x4*)(E2 + d2 * 64 + c0 + 8); float kv[8];
#pragma unroll
                    for (int e = 0; e < 4; ++e) { kv[e] = bf2f(Kb[((c0 + e) ^ dm2) * KST + dk]) * ea[e]; kv[4 + e] = bf2f(Kb[((c0 + 8 + e) ^ dm2) * KST + dk]) * eb[e]; }
                    o4 = (u32x4){pk2(kv[0], kv[1]), pk2(kv[2], kv[3]), pk2(kv[4], kv[5]), pk2(kv[6], kv[7])}; }
                *(u32x4*)(p.GFR_() + ((size_t)((chunk * GH + h) * 2 + d2) * GFRAGS + f) * 512 + lqq * 8) = o4; }
        }
        __syncthreads();
        if (wvq >= 2) {
#pragma unroll
          for (int q = 0; q < 3; ++q) { const int T = wvq - 2 + 6 * q; if (T < 16) { const int dt = T >> 3, nt = T & 7; f32x16 acc[2]; bf16x8 tf[2][4];
#pragma unroll
              for (int tm = 0; tm < 2; ++tm)
#pragma unroll
                  for (int ks = 0; ks < (tm ? 4 : 2); ++ks) tf[tm][ks] = *(const LAS bf16x8*)(Tb + (dt * 64 + 32 * tm + nq) * IST + 16 * ks + 8 * hhq);
#pragma unroll
              for (int tm = 0; tm < 2; ++tm) { const float z = zero_f();
#pragma unroll
                  for (int e = 0; e < 16; ++e) acc[tm][e] = z; }
#pragma unroll
              for (int ks = 0; ks < 4; ++ks)
#pragma unroll
                  for (int tm = (ks < 2 ? 0 : 1); tm < 2; ++tm) acc[tm] = MFMA32(tf[tm][ks], bfr[q][ks], acc[tm]);
              if (nt < 4) { float* up = p.GU_() + (size_t)((chunk * GH + h) * 2 + dt) * 8192 + nt * 2048 + lane * 4;
#pragma unroll
                  for (int tm = 0; tm < 2; ++tm)
#pragma unroll
                      for (int iq = 0; iq < 4; ++iq) *(f32x4*)(up + (tm * 4 + iq) * 256) = (f32x4){acc[tm][4 * iq], acc[tm][4 * iq + 1], acc[tm][4 * iq + 2], acc[tm][4 * iq + 3]}; }
              else { LAS bf16_t* wp = Ws + (dt * 64 + 4 * hhq) * KST + 32 * (nt - 4) + nq;
#pragma unroll
                  for (int tm = 0; tm < 2; ++tm)
#pragma unroll
                      for (int e = 0; e < 16; ++e) wp[(32 * tm + crow(e, 0)) * KST] = f2bf(acc[tm][e]); } } } }
        __syncthreads();
        { u32x2 wlo[4], whi[4];
#pragma unroll
          for (int q = 0; q < 4; ++q) { const int ft = wvq + 8 * q, d2 = ft >> 4, f = ft & 15; const LAS bf16_t* src = Ws + (d2 * 64 + 32 * (f >> 3) + nq) * KST + 16 * (f & 7) + 4 * hhq; wlo[q] = *(const LAS u32x2*)src; whi[q] = *(const LAS u32x2*)(src + 8); }
          __builtin_amdgcn_sched_barrier(0);
#pragma unroll
          for (int q = 0; q < 4; ++q) { const int ft = wvq + 8 * q, d2 = ft >> 4, f = ft & 15;
              *(u32x4*)(p.GFR_() + ((size_t)((chunk * GH + h) * 2 + d2) * GFRAGS + f) * 512 + lqq * 8) = (u32x4){wlo[q].x, wlo[q].y, whi[q].x, whi[q].y}; } }
#pragma unroll
        for (int q2 = 0; q2 < 2; ++q2) { const int ft = 32 + wvq + 8 * q2; u32x4 o4; int f, d2;
            { d2 = (ft >> 3) & 1; const int fl = ft & 7; f = 32 + fl; const int ci = 32 * (fl >> 2) + nq, c0 = 16 * (fl & 3) + 4 * hhq; const LAS float* gc = GC + d2 * 64;
                const float gci = gc[ci]; const f32x4 ga = *(const LAS f32x4*)(gc + c0), gb = *(const LAS f32x4*)(gc + c0 + 8);
                const LAS float* qs = QK + (d2 ? (63 - ci) * QST + 60 - c0 : ci * QST + c0); const f32x4 ra = *(const LAS f32x4*)qs, rb = *(const LAS f32x4*)(qs + (d2 ? -8 : 8)); float kv[8];
#pragma unroll
                for (int e = 0; e < 4; ++e) { const float xa = d2 ? ra[3 - e] : ra[e], xb = d2 ? rb[3 - e] : rb[e];
                    kv[e] = c0 + e <= ci ? xa * fexp(gci - ga[e]) : 0.f; kv[4 + e] = c0 + 8 + e <= ci ? xb * fexp(gci - gb[e]) : 0.f; }
                o4 = (u32x4){pk2(kv[0], kv[1]), pk2(kv[2], kv[3]), pk2(kv[4], kv[5]), pk2(kv[6], kv[7])}; }
            *(u32x4*)(p.GFR_() + ((size_t)((chunk * GH + h) * 2 + d2) * GFRAGS + f) * 512 + lqq * 8) = o4; }
        if (tid == 0 || tid == 256) p.GEG_()[(chunk * GH + h) * 2 + (tid >> 8)] = GE[(tid >> 8) * 64 + 63];
        asm volatile("" :: "v"(touch));
        __syncthreads();
    }
}
constexpr int SCAN_WGS = BATCH * GH * 2 * 2;
constexpr int SCAN_BUF = (GFRAGS + 16) * 1024;
static_assert(2 * SCAN_BUF <= LDS_BAR_OFF && SCAN_WGS <= NWG / 2, "scan LDS / workgroup split");
__device__ __forceinline__ void phase_gdn_scan(const Ptrs& p, LAS unsigned char* lds, int wg) {
    const int tid = opq((int)threadIdx.x), lane = tid & 63, wave = __builtin_amdgcn_readfirstlane(tid >> 6), hh = lane >> 5;
    constexpr int NSTEP = (CTX + SEQ) / 64;
    {
        const int task = (wg % 8) * (SCAN_WGS / 8) + wg / 8, pair = task & 1, d = (task >> 1) & 1, h = (task >> 2) % GH, b = task / (4 * GH);
        const int sl = 2 * pair + (wave & 1);
        f32x16 S[4];
#pragma unroll
        for (int kb = 0; kb < 4; ++kb)
            { const float z = zero_f();
#pragma unroll
            for (int v = 0; v < 16; ++v) S[kb][v] = z; }
#define GDN_CHUNK(k) ((k) < CTX / 64 ? NXCH + b * (CTX / 64) + (d ? CTX / 64 - 1 - (k) : (k)) : b * (SEQ / 64) + (d ? SEQ / 64 - 1 - ((k) - CTX / 64) : (k) - CTX / 64))
#define GDN_LOAD(k, buf) do { const int _pr = (GDN_CHUNK(k) * GH + h) * 2 + d; _Pragma("unroll") for (int _i = 0; _i < 9; ++_i) { const int _f = wave * 9 + _i; \
            const char* _src = _f < GFRAGS ? (const char*)(p.GFR_() + ((size_t)_pr * GFRAGS + _f) * 512) : (const char*)(p.GU_() + (size_t)_pr * 8192 + (2 * pair + (_f - GFRAGS) / 8) * 2048 + ((_f - GFRAGS) % 8) * 256); \
            __builtin_amdgcn_global_load_lds((const unsigned*)(_src + lane * 16), (LAS unsigned*)(lds + (buf) * SCAN_BUF + _f * 1024), 16, 0, 0); } } while (0)
        GDN_LOAD(0, 0);
        float egn = p.GEG_()[(GDN_CHUNK(0) * GH + h) * 2 + d];
#pragma unroll 1
        for (int k = 0; k < NSTEP; ++k) {
            asm volatile("s_waitcnt vmcnt(0)" ::: "memory"); __syncthreads();
            const float eg = egn; if (k + 1 < NSTEP) egn = p.GEG_()[(GDN_CHUNK(k + 1) * GH + h) * 2 + d];
            if (k + 1 < NSTEP) GDN_LOAD(k + 1, (k + 1) & 1);
            if (wave < 2) {
                const LAS unsigned char* fb = lds + (k & 1) * SCAN_BUF + lane * 16; const int chunk = GDN_CHUNK(k), prob = (chunk * GH + h) * 2 + d;
                const LAS unsigned char* ub = fb + (GFRAGS + wave * 8) * 1024;
#define FR(f) (*(const LAS bf16x8*)(fb + (f) * 1024))
                f32x16 ws[2], o[2];
#pragma unroll
                for (int cm = 0; cm < 2; ++cm)
                    { const float z = zero_f();
#pragma unroll
                    for (int v = 0; v < 16; ++v) { ws[cm][v] = z; o[cm][v] = z; } }
                bf16x8 fa[8], fc[8];
#define LDG1(dst, g) do { _Pragma("unroll") for (int _q = 0; _q < 2; ++_q) _Pragma("unroll") for (int _cm = 0; _cm < 2; ++_cm) { \
                    dst[_q * 4 + _cm * 2] = FR(_cm * 8 + 2 * (g) + _q); dst[_q * 4 + _cm * 2 + 1] = FR(16 + _cm * 8 + 2 * (g) + _q); } } while (0)
#define MMG1(src, g) do { _Pragma("unroll") for (int _q = 0; _q < 2; ++_q) { const int _ks = 2 * (g) + _q; const bf16x8 sbk = pack8(S[_ks >> 1], _ks & 1); \
                    _Pragma("unroll") for (int _cm = 0; _cm < 2; ++_cm) { ws[_cm] = MFMA32(src[_q * 4 + _cm * 2], sbk, ws[_cm]); o[_cm] = MFMA32(src[_q * 4 + _cm * 2 + 1], sbk, o[_cm]); } } } while (0)
                LDG1(fa, 0); __builtin_amdgcn_sched_barrier(0);
                LDG1(fc, 1); __builtin_amdgcn_sched_barrier(0); MMG1(fa, 0); __builtin_amdgcn_sched_barrier(0);
                LDG1(fa, 2); __builtin_amdgcn_sched_barrier(0); MMG1(fc, 1); __builtin_amdgcn_sched_barrier(0);
                LDG1(fc, 3); __builtin_amdgcn_sched_barrier(0); MMG1(fa, 2); __builtin_amdgcn_sched_barrier(0);
                f32x4 uu[8];
#pragma unroll
                for (int q = 0; q < 8; ++q) uu[q] = *(const LAS f32x4*)(ub + q * 1024);
                __builtin_amdgcn_sched_barrier(0); MMG1(fc, 3); __builtin_amdgcn_sched_barrier(0);
#undef LDG1
#undef MMG1
#pragma unroll
                for (int q = 0; q < 8; ++q) fa[q] = FR(32 + q);
                __builtin_amdgcn_sched_barrier(0);
                bf16x8 vb[4];
#pragma unroll
                for (int cm = 0; cm < 2; ++cm) { f32x16 vn;
#pragma unroll
                    for (int iq = 0; iq < 4; ++iq)
#pragma unroll
                        for (int e = 0; e < 4; ++e) vn[4 * iq + e] = uu[cm * 4 + iq][e] - ws[cm][4 * iq + e];
                    vb[2 * cm] = pack8(vn, 0); vb[2 * cm + 1] = pack8(vn, 1); }
                __builtin_amdgcn_sched_barrier(0);
#pragma unroll
                for (int q = 0; q < 8; ++q) fc[q] = FR(40 + q);
                __builtin_amdgcn_sched_barrier(0);
#pragma unroll
                for (int cm = 0; cm < 2; ++cm)
#pragma unroll
                    for (int ks = 0; ks < 4; ++ks) o[cm] = MFMA32(fa[cm * 4 + ks], vb[ks], o[cm]);
                __builtin_amdgcn_sched_barrier(0);
#pragma unroll
                for (int q = 0; q < 8; ++q) fa[q] = FR(48 + q);
                __builtin_amdgcn_sched_barrier(0);
#pragma unroll
                for (int kb = 0; kb < 2; ++kb) { S[kb] = S[kb] * eg;
#pragma unroll
                    for (int ks = 0; ks < 4; ++ks) S[kb] = MFMA32(fc[kb * 4 + ks], vb[ks], S[kb]); }
                __builtin_amdgcn_sched_barrier(0);
#pragma unroll
                for (int kb = 2; kb < 4; ++kb) { S[kb] = S[kb] * eg;
#pragma unroll
                    for (int ks = 0; ks < 4; ++ks) S[kb] = MFMA32(fa[(kb - 2) * 4 + ks], vb[ks], S[kb]); }
                int base, sbase, slen; chunk_rows(chunk, base, sbase, slen);
                const int sgn = d ? -BW : BW;
                bf16_t* op = (bf16_t*)p.GO_() + ((size_t)d * NR + base + (d ? 63 : 0)) * BW + h * GDK + sl * 32 + (lane & 31) + 4 * opq(hh) * sgn;
#pragma unroll
                for (int cm = 0; cm < 2; ++cm)
#pragma unroll
                    for (int v = 0; v < 16; v += 2) { const unsigned w = pk2(o[cm][v], o[cm][v + 1]); op[(32 * cm + crow(v, 0)) * sgn] = (bf16_t)w; op[(32 * cm + crow(v + 1, 0)) * sgn] = (bf16_t)(w >> 16); }
#undef FR
            }
        }
        __syncthreads();
#undef GDN_LOAD
#undef GDN_CHUNK
    }
}
constexpr float SWA_QSCALE = 0.125f * 1.4426950408889634f;
__device__ __forceinline__ void phase_swa_prep(const Ptrs& p, int l, int G, int wg) {
    const int tid = opq((int)threadIdx.x), lane = tid & 63, wave = tid >> 6, i = lane & 31, hsel = lane >> 5;
    const int m = i & 15; const float inv = exp2f(-(float)m * (13.287712379549449f / 16.0f));
    const f32x2 gq = *(const f32x2*)(p.swa_qnorm_g + l * HD + 2 * i), gk = *(const f32x2*)(p.swa_knorm_g + l * HD + 2 * i);
    unsigned wq[(QH + KVH) / 2], wn[(QH + KVH) / 2];
    constexpr int PA = 57, PC = 18, PB = 110; static_assert(128 * PA + 32 * PC + 96 * PB == NR, "prep row split");
    const int rbeg = wg < 128 ? wg * PA : wg < 160 ? 128 * PA + (wg - 128) * PC : 128 * PA + 32 * PC + (wg - 160) * PB, rend = rbeg + (wg < 128 ? PA : wg < 160 ? PC : PB);
    const int r0 = rbeg + wave;
    if (r0 < rend) {
#pragma unroll
        for (int it = 0; it < (QH + KVH) / 2; ++it) { const int hh = 2 * it + hsel; wq[it] = *(const unsigned*)(p.Pb_() + (size_t)r0 * LDP + (hh < QH ? C_SQ + hh * HD : C_SK + (hh - QH) * HD) + 2 * i); } }
#pragma unroll 1
    for (int r = r0; r < rend; r += 8) {
        const int rn = r + 8 < rend ? r + 8 : r;
#pragma unroll
        for (int it = 0; it < (QH + KVH) / 2; ++it) { const int hh = 2 * it + hsel; wn[it] = *(const unsigned*)(p.Pb_() + (size_t)rn * LDP + (hh < QH ? C_SQ + hh * HD : C_SK + (hh - QH) * HD) + 2 * i); }
        const bool isx = r < BX; const int t = isx ? r % SEQ : 0; const float pos = i < 16 ? (float)(t / GRID_W) : (float)(t % GRID_W);
        float sn = 0.f, cs = 1.f; if (isx) { const float rev = pos * inv * 0.15915494309189535f; sn = __builtin_amdgcn_sinf(rev); cs = __builtin_amdgcn_cosf(rev); }
#pragma unroll
        for (int it = 0; it < (QH + KVH) / 2; ++it) { const int hh = 2 * it + hsel; const bool isq = hh < QH;
            const unsigned w2 = wq[it];
            const float a = __uint_as_float(w2 << 16), bb = __uint_as_float(w2 & 0xffff0000u);
            float ss = a * a + bb * bb; ss += shx(ss, 16, lane); ss += shx(ss, 8, lane); ss += shx(ss, 4, lane); ss += shx(ss, 2, lane); ss += shx(ss, 1, lane);
            const float rs = __builtin_amdgcn_rsqf(ss * (1.0f / HD) + EPS) * (isq ? SWA_QSCALE : 1.0f); const f32x2 gn = isq ? gq : gk;
            const float t1 = a * rs * gn[0], t2 = bb * rs * gn[1];
            const unsigned o = pk2(t1 * cs - t2 * sn, t1 * sn + t2 * cs);
            if (isq) *(unsigned*)(p.SQb_() + (size_t)r * QH * HD + hh * HD + 2 * i) = o; else *(unsigned*)(p.SKb_() + (size_t)r * KVH * HD + (hh - QH) * HD + 2 * i) = o; }
#pragma unroll
        for (int it = 0; it < (QH + KVH) / 2; ++it) wq[it] = wn[it];
    }
}
constexpr int SST = 72, SSTV = 68  , SWA_XUNITS = BATCH * KVH * (SEQ / 64), SWA_UNITS = SWA_XUNITS + BATCH * KVH * (CTX / 64);
__device__ __forceinline__ void phase_swa_attn(const Ptrs& p, int l, LAS unsigned char* lds, int G, int wg, bool xonly) {
    const int tid = opq((int)threadIdx.x), lane = tid & 63, wave = tid >> 6, n = lane & 31, hh = lane >> 5, g = wave >> 1, th = wave & 1;
    const int lkey = tid >> 3, lc8 = (tid & 7) * 8;
    u32x4 kreg = {0u, 0u, 0u, 0u}, vreg = kreg, kr1 = kreg, vr1 = kreg, kr2 = kreg, vr2 = kreg;
    bool first = true;
    bf16x8 qfn[4];
    const int NU = xonly ? SWA_XUNITS : SWA_UNITS;
#define SWA_GEOM(u_, kvh_, bx_, cb_, jlo_, nl_, q0r_) do { const bool _isx = (u_) < SWA_XUNITS; const int _v = _isx ? (u_) : (u_) - SWA_XUNITS, _nqb = _isx ? SEQ / 64 : CTX / 64, _b = _v / (KVH * _nqb), _q0 = (_v % _nqb) * 64; \
        kvh_ = (_v / _nqb) % KVH; cb_ = BX + _b * CTX; bx_ = _b * SEQ + _q0 - 128; q0r_ = (_isx ? _b * SEQ : BX + _b * CTX) + _q0; jlo_ = _isx ? (_q0 >= 128 ? 0 : (128 - _q0) / 64) : 0; \
        const int _jhi = _isx ? ((SEQ - 1 - (_q0 - 128)) / 64 < 4 ? (SEQ - 1 - (_q0 - 128)) / 64 : 4) : -1; nl_ = _jhi - jlo_ + 1; } while (0)
#define SWA_LOADG(kd, vd, vt_, kvh_, bx_, cb_, jlo_, nl_) do { const size_t _r = (size_t)((vt_) < (nl_) ? (bx_) + 64 * ((jlo_) + (vt_)) : (cb_) + 64 * ((vt_) - (nl_))) + lkey; \
        kd = *(const u32x4*)(p.SKb_() + _r * KVH * HD + (kvh_) * HD + lc8); vd = *(const u32x4*)(p.Pb_() + _r * LDP + C_SV + (kvh_) * HD + lc8); } while (0)
#pragma unroll 1
    for (int u = wg; u < NU; u += G) {
        const bool isx = u < SWA_XUNITS; const int v = isx ? u : u - SWA_XUNITS, nqb = isx ? SEQ / 64 : CTX / 64;
        const int b = v / (KVH * nqb), kvh = (v / nqb) % KVH, qb = v % nqb, q0 = qb * 64, hq = kvh * SGRP + g;
        const int cbase = BX + b * CTX, xbase = b * SEQ;
        const int jlo = isx ? (q0 >= 128 ? 0 : (128 - q0) / 64) : 0, jhi = isx ? ((SEQ - 1 - (q0 - 128)) / 64 < 4 ? (SEQ - 1 - (q0 - 128)) / 64 : 4) : -1, nl = jhi - jlo + 1, nt = nl + CTX / 64;
        const size_t qrow = (size_t)(isx ? xbase : cbase) + q0 + 32 * th + n;
        bf16x8 qf[4];
        if (first) {
#pragma unroll
            for (int ks = 0; ks < 4; ++ks) qf[ks] = *(const bf16x8*)(p.SQb_() + qrow * QH * HD + hq * HD + 16 * ks + 8 * hh); }
        else {
#pragma unroll
            for (int ks = 0; ks < 4; ++ks) qf[ks] = qfn[ks]; }
        float mrun = p.swa_sink[l * QH + hq] * 1.4426950408889634f, lsum = 1.0f;
        f32x16 O[2];
#pragma unroll
        for (int dt = 0; dt < 2; ++dt)
            { const float z = zero_f();
#pragma unroll
            for (int e = 0; e < 16; ++e) O[dt][e] = z; }
#define SWA_TROW(vt) ((vt) < nl ? xbase + q0 - 128 + 64 * (jlo + (vt)) : cbase + 64 * ((vt) - nl))
#define SWA_LOADT(kd, vd, vt_) do { const size_t _r = (size_t)SWA_TROW(vt_) + lkey; kd = *(const u32x4*)(p.SKb_() + _r * KVH * HD + kvh * HD + lc8); vd = *(const u32x4*)(p.Pb_() + _r * LDP + C_SV + kvh * HD + lc8); } while (0)
        if (first) { SWA_LOADT(kreg, vreg, 0); SWA_LOADT(kr1, vr1, 1); SWA_LOADT(kr2, vr2, 2); first = false; }
        const int un = u + G; const bool has_next = un < NU; int n_kvh = 0, n_bx = 0, n_cb = 0, n_jlo = 0, n_nl = 0, n_q0r = 0; if (has_next) { SWA_GEOM(un, n_kvh, n_bx, n_cb, n_jlo, n_nl, n_q0r);
#pragma unroll
            for (int ks = 0; ks < 4; ++ks) qfn[ks] = *(const bf16x8*)(p.SQb_() + (size_t)(n_q0r + 32 * th + n) * QH * HD + (n_kvh * SGRP + g) * HD + 16 * ks + 8 * hh); }
#pragma unroll 1
        for (int vt = 0; vt < nt; ++vt) {
            LAS bf16_t* KS = (LAS bf16_t*)(lds + (vt & 1) * (2 * 64 * SST * 2)); LAS bf16_t* VT = KS + 64 * SST;
            *(LAS u32x4*)(KS + lkey * SST + lc8) = kreg;
            { const unsigned w4[4] = {vreg.x, vreg.y, vreg.z, vreg.w};
#pragma unroll
              for (int e = 0; e < 4; ++e) { VT[(lc8 + 2 * e) * SSTV + lkey] = (bf16_t)(w4[e] & 0xffffu); VT[(lc8 + 2 * e + 1) * SSTV + lkey] = (bf16_t)(w4[e] >> 16); } }
            __syncthreads();
            kreg = kr1; vreg = vr1; kr1 = kr2; vr1 = vr2; if (vt + 3 < nt) SWA_LOADT(kr2, vr2, vt + 3); else if (has_next) SWA_LOADG(kr2, vr2, vt + 3 - nt, n_kvh, n_bx, n_cb, n_jlo, n_nl);
            f32x16 S[2];
            bf16x8 kf[8]; u32x2 vlo[8], vhi[8];
#pragma unroll
            for (int q = 0; q < 8; ++q) kf[q] = *(const LAS bf16x8*)(KS + (32 * (q >> 2) + n) * SST + 16 * (q & 3) + 8 * hh);
            __builtin_amdgcn_sched_barrier(0);
#pragma unroll
            for (int q = 0; q < 8; ++q) { const LAS bf16_t* vr = VT + (32 * (q & 1) + n) * SSTV + 16 * (q >> 1) + 4 * hh; vlo[q] = *(const LAS u32x2*)vr; vhi[q] = *(const LAS u32x2*)(vr + 8); }
            __builtin_amdgcn_sched_barrier(0);
#pragma unroll
            for (int km = 0; km < 2; ++km) {
                { const float z = zero_f();
#pragma unroll
                for (int e = 0; e < 16; ++e) S[km][e] = z; }
#pragma unroll
                for (int ks = 0; ks < 4; ++ks) S[km] = MFMA32(kf[km * 4 + ks], qf[ks], S[km]); }
            __builtin_amdgcn_sched_barrier(0);
            if (vt < nl) { const int j = jlo + vt;
                if (j == 0 || j == 4) { const int qt = 32 * th + n;
#pragma unroll
                    for (int km = 0; km < 2; ++km)
#pragma unroll
                        for (int e = 0; e < 16; ++e) { const int ko = -128 + 64 * j + 32 * km + crow(e, hh); const bool ok = j == 0 ? ko >= qt - 128 : ko <= qt + 128; S[km][e] = ok ? S[km][e] : -1e30f; } } }
            float mx = S[0][0];
#pragma unroll
            for (int km = 0; km < 2; ++km)
#pragma unroll
                for (int e = 0; e < 16; ++e) mx = fmaxf(mx, S[km][e]);
            mx = fmaxf(mx, shx(mx, 32, lane)); const float mnew = fmaxf(mrun, mx), alpha = __builtin_amdgcn_exp2f(mrun - mnew); mrun = mnew;
            float rsum = 0.f;
#pragma unroll
            for (int km = 0; km < 2; ++km)
#pragma unroll
                for (int e = 0; e < 16; ++e) { S[km][e] = __builtin_amdgcn_exp2f(S[km][e] - mnew); rsum += S[km][e]; }
            rsum += shx(rsum, 32, lane); lsum = lsum * alpha + rsum;
#pragma unroll
            for (int dt = 0; dt < 2; ++dt) O[dt] = O[dt] * alpha;
#pragma unroll
            for (int ks = 0; ks < 4; ++ks) { const bf16x8 pb = pack8(S[ks >> 1], ks & 1);
#pragma unroll
                for (int dt = 0; dt < 2; ++dt) O[dt] = MFMA32(__builtin_bit_cast(bf16x8, (u32x4){vlo[ks * 2 + dt].x, vlo[ks * 2 + dt].y, vhi[ks * 2 + dt].x, vhi[ks * 2 + dt].y}), pb, O[dt]); }
        }
#undef SWA_TROW
#undef SWA_LOADT
        const float il = 1.0f / lsum; bf16_t* op = p.BRb_() + qrow * 3 * BW + BW + hq * HD + 4 * hh;
#pragma unroll
        for (int dt = 0; dt < 2; ++dt)
#pragma unroll
            for (int gq = 0; gq < 4; ++gq) *(u32x2*)(op + 32 * dt + 8 * gq) = (u32x2){pk2(O[dt][4 * gq] * il, O[dt][4 * gq + 1] * il), pk2(O[dt][4 * gq + 2] * il, O[dt][4 * gq + 3] * il)};
        __syncthreads();
    }
}

constexpr int UST = 520;
template <int DIR> __device__ __forceinline__ void lru_scan_tile(f32x16 (&A)[2], f32x16 (&B)[2], int hh, int lane) {
    float h = 0.f, P = 1.f;
#pragma unroll
    for (int gi = 0; gi < 8; ++gi) { const int g2 = DIR ? 7 - gi : gi, tm = g2 >> 2, vg = g2 & 3;
        float rh[4], rP[4];
        { float ch = h, cP = P;
#pragma unroll
          for (int e = 0; e < 4; ++e) { const int v = 4 * vg + (DIR ? 3 - e : e); ch = A[tm][v] * ch + B[tm][v]; cP = A[tm][v] * cP; }
          const float th = shx(ch, 32, lane), tP = shx(cP, 32, lane);
          const bool second = DIR ? hh == 0 : hh == 1; ch = second ? th : h; cP = second ? tP : P;
#pragma unroll
          for (int e = 0; e < 4; ++e) { const int v = 4 * vg + (DIR ? 3 - e : e); ch = A[tm][v] * ch + B[tm][v]; cP = A[tm][v] * cP; rh[e] = ch; rP[e] = cP; }
          h = shx(ch, 32, lane); P = shx(cP, 32, lane); }
#pragma unroll
        for (int e = 0; e < 4; ++e) { const int v = 4 * vg + (DIR ? 3 - e : e); B[tm][v] = rh[e]; A[tm][v] = rP[e]; }
    }
}
__device__ __forceinline__ void phase_lru_local(const Ptrs& p, int l, LAS unsigned char* lds, int G, int wg) {
    const int tid = opq((int)threadIdx.x), lane = tid & 63, wave = tid >> 6, n = lane & 31, hh = lane >> 5;
    LAS bf16_t* Ub = (LAS bf16_t*)lds;
#pragma unroll 1
    for (int it = 0; it < 2; ++it) {
        const int chunk = it == 0 ? wg : (wg >= NWG / 2 && wg - NWG / 2 < NCHUNK - NWG ? NWG + wg - NWG / 2 : -1);
        if (chunk < 0 || chunk >= NCHUNK) continue;
        int base, sbase, slen; chunk_rows(chunk, base, sbase, slen);
        const int kb = wave;
        bf16x8 wbr[4], wbi[4]; float pbr, pbi, plm;
#define LRU_WLOAD(q) do { const int _d = (q) >> 1, _tn = (q) & 1, _c = kb * 64 + 32 * _tn + n; const bf16_t* _wr = p.Wt_lg_() + ((size_t)((_d * 2 + 0) * LB + kb) * LBW + 32 * _tn + n) * LBW + 8 * hh; const bf16_t* _wi = _wr + (size_t)LB * LBW * LBW; \
            _Pragma("unroll") for (int _ks = 0; _ks < 4; ++_ks) { wbr[_ks] = *(const bf16x8*)(_wr + 16 * _ks); wbi[_ks] = *(const bf16x8*)(_wi + 16 * _ks); } \
            pbr = p.lru_gate_b[((l * 2 + _d) * 2 + 0) * LW + _c]; pbi = p.lru_gate_b[((l * 2 + _d) * 2 + 1) * LW + _c]; plm = p.lru_lambda[(l * 2 + _d) * LW + _c]; } while (0)
        LRU_WLOAD(0);
        { const int cp = tid & 255, half = tid >> 8;
          float w[4][2];
#pragma unroll
          for (int j = 0; j < 4; ++j) { const f32x2 w2 = *(const f32x2*)(p.lru_conv_w + ((size_t)l * 4 + j) * LW + 2 * cp); w[j][0] = w2[0]; w[j][1] = w2[1]; }
          const f32x2 bias = *(const f32x2*)(p.lru_conv_b + l * LW + 2 * cp);
          unsigned xr[35];
#pragma unroll
          for (int j = 0; j < 35; ++j) { const int r = base + 32 * half + j - 2; xr[j] = (r >= sbase && r < sbase + slen) ? *(const unsigned*)(p.Pb_() + (size_t)r * LDP + C_LX + 2 * cp) : 0u; }
#pragma unroll
          for (int t = 0; t < 32; ++t) {
              float u0 = bias[0], u1 = bias[1];
#pragma unroll
              for (int j = 0; j < 4; ++j) { u0 += w[j][0] * __uint_as_float(xr[t + j] << 16); u1 += w[j][1] * __uint_as_float(xr[t + j] & 0xffff0000u); }
              *(LAS unsigned*)(Ub + (32 * half + t) * UST + 2 * cp) = pk2(u0, u1); } }
        __syncthreads();
#pragma unroll 1
        for (int dt2 = 0; dt2 < 4; ++dt2) { const int d = dt2 >> 1, tn = dt2 & 1;
            f32x16 A2[2], B2[2];
#pragma unroll
            for (int tm = 0; tm < 2; ++tm)
                { const float z = zero_f();
#pragma unroll
                for (int e = 0; e < 16; ++e) { A2[tm][e] = z; B2[tm][e] = z; } }
            { bf16x8 af[4][2];
#pragma unroll
              for (int ks = 0; ks < 4; ++ks)
#pragma unroll
                  for (int tm = 0; tm < 2; ++tm) af[ks][tm] = *(const LAS bf16x8*)(Ub + (32 * tm + n) * UST + kb * 64 + 16 * ks + 8 * hh);
              __builtin_amdgcn_sched_barrier(0);
#pragma unroll
              for (int ks = 0; ks < 4; ++ks)
#pragma unroll
                  for (int tm = 0; tm < 2; ++tm) { A2[tm] = MFMA32(af[ks][tm], wbr[ks], A2[tm]); B2[tm] = MFMA32(af[ks][tm], wbi[ks], B2[tm]); } }
            const int c = kb * 64 + 32 * tn + n;
            const float br_ = pbr, bi_ = pbi, sp8 = -8.0f * softplusf_(-plm);
            if (dt2 < 3) LRU_WLOAD(dt2 + 1);
            const LAS bf16_t* ub = Ub + 4 * opq(hh) * UST + c;
#pragma unroll
            for (int tm = 0; tm < 2; ++tm)
#pragma unroll
                for (int e = 0; e < 16; ++e) { const float la = sp8 * sigmoidf_(A2[tm][e] + br_), uu = bf2f(ub[(32 * tm + crow(e, 0)) * UST]);
                    const float y = 2.0f * la; A2[tm][e] = fexp(la);
                    const float om = y > -0.5f ? -y * (1.0f + y * (0.5f + y * (0.16666667f + y * (0.041666668f + y * (0.0083333338f + y * 0.0013888889f))))) : 1.0f - A2[tm][e] * A2[tm][e];
                    B2[tm][e] = __builtin_amdgcn_sqrtf(om) * (sigmoidf_(B2[tm][e] + bi_) * uu); }
            if (d == 0) lru_scan_tile<0>(A2, B2, hh, lane); else lru_scan_tile<1>(A2, B2, hh, lane);
            unsigned* ha = (unsigned*)p.LA_() + ((size_t)d * NR + base + 4 * opq(hh)) * LW + c;
#pragma unroll
            for (int tm = 0; tm < 2; ++tm)
#pragma unroll
                for (int e = 0; e < 16; ++e) { const int t = 32 * tm + crow(e, 0); ha[(size_t)t * LW] = pk2(B2[tm][e], A2[tm][e]); }
            if (hh == (d ? 0 : 1)) { p.LSA_()[((size_t)d * NCHUNK + chunk) * LW + c] = d ? A2[0][0] : A2[1][15]; p.LSH_()[((size_t)d * NCHUNK + chunk) * LW + c] = d ? B2[0][0] : B2[1][15]; }
        }
        __syncthreads();
    }
}
#undef LRU_WLOAD
__device__ __forceinline__ void lru_carry_body(const Ptrs& p, const long g) {
    if (g >= (long)BATCH * 2 * LW) return; const int c = (int)(g % LW), d = (int)(g / LW) % 2, b = (int)(g / (2 * LW)); float carry = 0.f;
    constexpr int NK = (CTX + SEQ) / 64; float sa[NK], sh[NK];
#define LRU_CHUNK_OF(k) ((k) < CTX / 64 ? NXCH + b * (CTX / 64) + (d ? CTX / 64 - 1 - (k) : (k)) : b * (SEQ / 64) + (d ? SEQ / 64 - 1 - ((k) - CTX / 64) : (k) - CTX / 64))
#pragma unroll
    for (int k = 0; k < NK; ++k) { const size_t o = ((size_t)d * NCHUNK + LRU_CHUNK_OF(k)) * LW + c; sa[k] = p.LSA_()[o]; sh[k] = p.LSH_()[o]; }
#pragma unroll
    for (int k = 0; k < NK; ++k) { const size_t o = ((size_t)d * NCHUNK + LRU_CHUNK_OF(k)) * LW + c; p.LSC_()[o] = carry; carry = sa[k] * carry + sh[k]; }
#undef LRU_CHUNK_OF
}
struct FinRow { u32x4 o0, o1; u32x4 zz, yy; u32x4 ha[2][2]; };
__device__ __forceinline__ void fin_load(FinRow& q, const Ptrs& p, int r, int lane) {
    const bf16_t* o0 = (const bf16_t*)p.GO_() + (size_t)r * BW + lane * 8;
    q.o0 = *(const u32x4*)o0; q.o1 = *(const u32x4*)(o0 + (size_t)NR * BW);
    q.zz = *(const u32x4*)(p.Pb_() + (size_t)r * LDP + C_Z + lane * 8); q.yy = *(const u32x4*)(p.Pb_() + (size_t)r * LDP + C_LY + lane * 8);
#pragma unroll
    for (int d = 0; d < 2; ++d) { const size_t o = ((size_t)d * NR + r) * LW + lane * 8;
        q.ha[d][0] = *(const u32x4*)((const unsigned*)p.LA_() + o); q.ha[d][1] = *(const u32x4*)((const unsigned*)p.LA_() + o + 4); }
}
__device__ __forceinline__ void phase_finish(const Ptrs& p, int l, int G, int wg) {
    const int tid = opq((int)threadIdx.x), lane = tid & 63, wave = tid >> 6;
    const f32x4 g0 = *(const f32x4*)(p.gdn_onorm_g + l * GDK + (lane & 15) * 8), g1 = *(const f32x4*)(p.gdn_onorm_g + l * GDK + (lane & 15) * 8 + 4);
    constexpr int PER = NR / (NWG * 8); static_assert(NR % (NWG * 8) == 0, "rows per wave");
    const int r0 = (wg * 8 + wave) * PER;
    FinRow cur, nxt; fin_load(cur, p, r0, lane);
    f32x4 lc[2][2]; int chunk_cur = -1;
#pragma unroll 1
    for (int k = 0; k < PER; ++k) { const int r = r0 + k;
        const int chunk = r < BX ? r / 64 : NXCH + (r - BX) / 64;
        fin_load(nxt, p, k + 1 < PER ? r + 1 : r, lane);
        if (chunk != chunk_cur) { chunk_cur = chunk;
#pragma unroll
            for (int d = 0; d < 2; ++d) { const size_t oc = ((size_t)d * NCHUNK + chunk) * LW + lane * 8; lc[d][0] = *(const f32x4*)(p.LSC_() + oc); lc[d][1] = *(const f32x4*)(p.LSC_() + oc + 4); } }
        { const f32x4 a = bf4((u32x2){cur.o0.x, cur.o0.y}) + bf4((u32x2){cur.o1.x, cur.o1.y}), b = bf4((u32x2){cur.o0.z, cur.o0.w}) + bf4((u32x2){cur.o1.z, cur.o1.w});
          float ss = a[0] * a[0] + a[1] * a[1] + a[2] * a[2] + a[3] * a[3] + b[0] * b[0] + b[1] * b[1] + b[2] * b[2] + b[3] * b[3];
          ss += shx(ss, 8, lane); ss += shx(ss, 4, lane); ss += shx(ss, 2, lane); ss += shx(ss, 1, lane);
          const float rs = __builtin_amdgcn_rsqf(ss * (1.0f / GDK) + EPS);
          const f32x4 z0 = bf4((u32x2){cur.zz.x, cur.zz.y}), z1 = bf4((u32x2){cur.zz.z, cur.zz.w});
          f32x4 y0 = a * rs * g0, y1 = b * rs * g1;
#pragma unroll
          for (int e = 0; e < 4; ++e) { y0[e] *= siluf_(z0[e]); y1[e] *= siluf_(z1[e]); }
          *(u32x4*)(p.BRb_() + (size_t)r * 3 * BW + lane * 8) = (u32x4){pk2(y0[0], y0[1]), pk2(y0[2], y0[3]), pk2(y1[0], y1[1]), pk2(y1[2], y1[3])}; }
        { f32x4 h0, h1;
#pragma unroll
          for (int e = 0; e < 4; ++e) {
              h0[e] = (__uint_as_float(cur.ha[0][0][e] << 16) + __uint_as_float(cur.ha[0][0][e] & 0xffff0000u) * lc[0][0][e]) + (__uint_as_float(cur.ha[1][0][e] << 16) + __uint_as_float(cur.ha[1][0][e] & 0xffff0000u) * lc[1][0][e]);
              h1[e] = (__uint_as_float(cur.ha[0][1][e] << 16) + __uint_as_float(cur.ha[0][1][e] & 0xffff0000u) * lc[0][1][e]) + (__uint_as_float(cur.ha[1][1][e] << 16) + __uint_as_float(cur.ha[1][1][e] & 0xffff0000u) * lc[1][1][e]); }
          const f32x4 y0 = bf4((u32x2){cur.yy.x, cur.yy.y}), y1 = bf4((u32x2){cur.yy.z, cur.yy.w});
#pragma unroll
          for (int e = 0; e < 4; ++e) { h0[e] *= geluf_(y0[e]); h1[e] *= geluf_(y1[e]); }
          *(u32x4*)(p.BRb_() + (size_t)r * 3 * BW + 2 * BW + lane * 8) = (u32x4){pk2(h0[0], h0[1]), pk2(h0[2], h0[3]), pk2(h1[0], h1[1]), pk2(h1[2], h1[3])}; }
        cur = nxt;
    }
}

#ifndef PROBE_MASK
#define PROBE_MASK 0
#endif
struct Args { Ptrs p; unsigned* bar; int ph_lo, ph_hi; };
#define STRIDE_LOOP(n, call) do { _Pragma("unroll 1") for (long g = (long)blockIdx.x * NTHREADS + opq((int)threadIdx.x); g < (long)(n); g += (long)NWG * NTHREADS) { call; } } while (0)
__global__ void __launch_bounds__(NTHREADS, 2) mega_fwd(Args a) {
    extern __shared__ __attribute__((aligned(16))) unsigned char lds_raw[];
    LAS unsigned char* lds = (LAS unsigned char*)lds_raw;
    Ptrs p = a.p, pn = a.p; constexpr int G = NWG; const int wg = blockIdx.x;
    volatile LAS unsigned* bst = (volatile LAS unsigned*)(lds + LDS_BAR_OFF);
    if (threadIdx.x == 0) { bst[0] = 0u; bst[1] = 0u; bst[2] = 0u; bst[3] = 0u; }
    __syncthreads();
    const XcdBarrier bar = xcd_barrier_post(a.bar, bst);
#define GRID_BAR() xcd_barrier(bar)
    phase_adaln(p, (LAS float*)lds, G, wg);
    GRID_BAR();
    for (int l = 0; l < DEPTH; ++l) { const bool last = l == DEPTH - 1; p.wofs = (l & 1) * WSET; pn.wofs = ((l + 1) & 1) * WSET;
        cvt_weights_small(p, l, G, wg);
        { const int tidq = opq((int)threadIdx.x), wv = tidq >> 6;
#pragma unroll 1
          for (int pass = 0; pass < 2; ++pass) {
              if ((pass == 0) == (wv < 4)) { for (int _r = 0; _r <= ((PROBE_MASK >> 0) & 1); ++_r) cvt_weights_wave(p, l, (LAS float*)lds + wv * (64 * 65), l == 0 ? 0 : CF_ALL, CT_ALL, wg * 8 + wv, G * 8, tidq & 63); }
              else phase_rows<MODE_N1>(p, l, (LAS float*)lds, G, wg); } }
        GRID_BAR();
        for (int _r = 0; _r <= ((PROBE_MASK >> 1) & 1); ++_r) {
        phase_gemm_in(p, lds, G, wg);
        }
        GRID_BAR();
        for (int _r = 0; _r <= ((PROBE_MASK >> 2) & 1); ++_r) {
        phase_gdn_local(p, l, lds, G, wg);
        }
        for (int _r = 0; _r <= ((PROBE_MASK >> 3) & 1); ++_r) {
        phase_swa_prep(p, l, G, wg);
        phase_lru_local(p, l, lds, G, wg);
        }
        GRID_BAR();
        if (wg < SCAN_WGS) {
            for (int _r = 0; _r <= ((PROBE_MASK >> 5) & 1); ++_r) phase_gdn_scan(p, lds, wg);
        } else {
            for (int _r = 0; _r <= ((PROBE_MASK >> 4) & 1); ++_r) phase_swa_attn(p, l, lds, G - SCAN_WGS, wg - SCAN_WGS, last);
#pragma unroll 1
            for (long g = (long)(G - 1 - (int)blockIdx.x) * NTHREADS + opq((int)threadIdx.x); g < (long)BATCH * 2 * LW; g += (long)G * NTHREADS) lru_carry_body(p, g);
        }
        GRID_BAR();
        for (int _r = 0; _r <= ((PROBE_MASK >> 6) & 1); ++_r) {
        phase_finish(p, l, G, wg);
        }
        GRID_BAR();
        for (int _r = 0; _r <= ((PROBE_MASK >> 7) & 1); ++_r) {
        phase_gemm_branch(p, lds, G, wg, last);
        }
        GRID_BAR();
        phase_gemm_out(p, pn, l, lds, G, wg, last);
        GRID_BAR();
        for (int _r = 0; _r <= ((PROBE_MASK >> 8) & 1); ++_r) {
        if (last) phase_rows<MODE_N2, true>(p, l, (LAS float*)lds, G, wg); else phase_rows<MODE_N2, false>(p, l, (LAS float*)lds, G, wg);
        }
        GRID_BAR();
        for (int _r = 0; _r <= ((PROBE_MASK >> 9) & 1); ++_r) {
        phase_rank(p, (LAS unsigned*)lds, G, wg, last);
        }
        GRID_BAR();
        for (int _r = 0; _r <= ((PROBE_MASK >> 10) & 1); ++_r) {
        phase_gemm_gu(p, lds, G, wg, last);
        }
        GRID_BAR();
        for (int _r = 0; _r <= ((PROBE_MASK >> 11) & 1); ++_r) {
        phase_gemm_down(p, pn, l, lds, G, wg, last);
        }
        GRID_BAR();
    }
    phase_rows<MODE_FINAL>(p, DEPTH, (LAS float*)lds, G, wg);
}

extern "C" void kernel_launch(void* const* d_in, const int* in_sizes, int n_in, void* d_out, int out_size, void* d_ws, size_t ws_size, hipStream_t stream) {
    Args a{}; Ptrs& p = a.p;
    const float** ins = (const float**)&p.x; for (int i = 0; i < 27; ++i) ins[i] = (const float*)d_in[i];
    p.out = (float*)d_out;
    p.ws = (char*)d_ws; p.wofs = 0; a.bar = (unsigned*)((char*)d_ws + O_bar); const size_t off = WS_END;
    if (off > ws_size) { fprintf(stderr, "kernel_launch: workspace too small: need %zu have %zu\n", off, ws_size); return; }
    (void)in_sizes; (void)n_in; (void)out_size;
    static int grid = 0;
    if (grid == 0) {
        int dev = 0, cus = 0, per_cu = 0;
        if (hipGetDevice(&dev) != hipSuccess || hipDeviceGetAttribute(&cus, hipDeviceAttributeMultiprocessorCount, dev) != hipSuccess || cus <= 0) { fprintf(stderr, "kernel_launch: device query failed\n"); grid = -1; return; }
        if (hipFuncSetAttribute((const void*)mega_fwd, hipFuncAttributeMaxDynamicSharedMemorySize, LDS_BYTES) != hipSuccess) { fprintf(stderr, "kernel_launch: hipFuncSetAttribute failed\n"); grid = -1; return; }
        if (hipOccupancyMaxActiveBlocksPerMultiprocessor(&per_cu, (const void*)mega_fwd, NTHREADS, LDS_BYTES) != hipSuccess || per_cu < 1) fprintf(stderr, "kernel_launch: occupancy query reports %d workgroups per CU\n", per_cu);
        (void)hipGetLastError();
        if (cus < NWG) { fprintf(stderr, "kernel_launch: built for a %d-CU device, found %d CUs; nothing launched\n", NWG, cus); grid = -1; return; }
        grid = NWG;
    }
    if (grid < 0) return;
    (void)hipMemsetAsync(a.bar, 0, (size_t)XCD_BAR_WORDS * 4, stream);
    a.ph_lo = 0; a.ph_hi = 1 << 30;
    hipLaunchKernelGGL(mega_fwd, dim3(grid), dim3(NTHREADS), LDS_BYTES, stream, a);
}
```
